# Optimizing an MI355X kernel written in HIP

```python
import jax, jax.numpy as jnp
from jax import lax
import numpy as np

D_MODEL = 1024
BATCH = 4
SEQ = 8192
DEPTH = 1

GRID_W = 64
CTX_LEN = 256
N_HEADS = 8
N_KV_HEADS = 2
HEAD_DIM = 64
KV_GROUP = N_HEADS // N_KV_HEADS
ATTN_WIDTH = N_HEADS * HEAD_DIM
KV_WIDTH = N_KV_HEADS * HEAD_DIM
WINDOW = 128
BLOCK = 128
ROPE_THETA = 10000.0
POOL_WINDOWS = (2, 4, 8, 16)
N_POOL_GROUPS = 4
POOL_WIDTH = D_MODEL - ATTN_WIDTH
POOL_GROUP_DIM = POOL_WIDTH // N_POOL_GROUPS
MIX_WIDTH = ATTN_WIDTH + POOL_WIDTH
IN_COLS = ATTN_WIDTH + 2 * KV_WIDTH + POOL_WIDTH
N_EXPERTS = 64
TOP_K = 8
N_EXPERT_GROUPS = 8
EXPERTS_PER_GROUP = N_EXPERTS // N_EXPERT_GROUPS
TOPK_GROUPS = 4
D_EXPERT = 256
D_SHARED = 256
ROUTED_SCALE = 2.5
EXPERT_BLOCK = 128
EPS = 1e-6

kernel_name = "hybrid_window_gqa_pool_moe_dit_layer"

F32 = jnp.float32


def rmsnorm(x, g):
    x32 = x.astype(F32)
    y = x32 * lax.rsqrt(jnp.mean(x32 * x32, axis=-1, keepdims=True) + EPS)
    return (y * g.astype(F32)).astype(x.dtype)


def modulate(h, shift, scale):
    return h * (1 + scale) + shift


def axial_rope_tables(n_tokens):
    rows = n_tokens // GRID_W
    row = jnp.repeat(jnp.arange(rows), GRID_W).astype(F32)
    col = jnp.tile(jnp.arange(GRID_W), rows).astype(F32)
    n_freq = HEAD_DIM // 4
    inv_freq = ROPE_THETA ** (-jnp.arange(n_freq, dtype=F32) / n_freq)
    ang_r = row[:, None] * inv_freq[None, :]
    ang_c = col[:, None] * inv_freq[None, :]
    return jnp.cos(ang_r), jnp.sin(ang_r), jnp.cos(ang_c), jnp.sin(ang_c)


def _rope_half(x, cos, sin):
    x1, x2 = jnp.split(x, 2, axis=-1)
    cos = cos[:, None, :]
    sin = sin[:, None, :]
    return jnp.concatenate([x1 * cos - x2 * sin, x1 * sin + x2 * cos], axis=-1)


def apply_axial_rope(x, tables):
    cos_r, sin_r, cos_c, sin_c = tables
    xr, xc = jnp.split(x.astype(F32), 2, axis=-1)
    return jnp.concatenate([_rope_half(xr, cos_r, sin_r), _rope_half(xc, cos_c, sin_c)], axis=-1).astype(x.dtype)


def split_projection(z):
    B, L = z.shape[:2]
    q = z[..., :ATTN_WIDTH].reshape(B, L, N_HEADS, HEAD_DIM)
    k = z[..., ATTN_WIDTH:ATTN_WIDTH + KV_WIDTH].reshape(B, L, N_KV_HEADS, HEAD_DIM)
    v = z[..., ATTN_WIDTH + KV_WIDTH:ATTN_WIDTH + 2 * KV_WIDTH].reshape(B, L, N_KV_HEADS, HEAD_DIM)
    p = z[..., ATTN_WIDTH + 2 * KV_WIDTH:]
    return q, k, v, p


def split_kv(z):
    B, L = z.shape[:2]
    k = z[..., :KV_WIDTH].reshape(B, L, N_KV_HEADS, HEAD_DIM)
    v = z[..., KV_WIDTH:].reshape(B, L, N_KV_HEADS, HEAD_DIM)
    return k, v


def latent_window_attention(q, k, v, k_ctx, v_ctx, sink):
    B, S = q.shape[:2]
    nb = S // BLOCK
    scale = HEAD_DIM ** -0.5
    qb = q.reshape(B, nb, BLOCK, N_KV_HEADS, KV_GROUP, HEAD_DIM)

    def band(t):
        tp = jnp.pad(t, ((0, 0), (BLOCK, BLOCK), (0, 0), (0, 0))).reshape(B, nb + 2, BLOCK, N_KV_HEADS, HEAD_DIM)
        return jnp.concatenate([tp[:, :-2], tp[:, 1:-1], tp[:, 2:]], axis=2)

    kb, vb = band(k), band(v)
    s_loc = jnp.einsum('bnqkgd,bnjkd->bnkgqj', qb, kb, preferred_element_type=F32) * scale
    s_ctx = jnp.einsum('bnqkgd,bckd->bnkgqc', qb, k_ctx, preferred_element_type=F32) * scale
    q_pos = jnp.arange(nb)[:, None, None] * BLOCK + jnp.arange(BLOCK)[None, :, None]
    k_pos = jnp.arange(nb)[:, None, None] * BLOCK - BLOCK + jnp.arange(3 * BLOCK)[None, None, :]
    allowed = (jnp.abs(q_pos - k_pos) <= WINDOW) & (k_pos >= 0) & (k_pos < S)
    s_loc = jnp.where(allowed[None, :, None, None], s_loc, -jnp.inf)
    sink_l = sink.astype(F32).reshape(1, 1, N_KV_HEADS, KV_GROUP, 1, 1)
    m = jnp.maximum(jnp.maximum(s_loc.max(-1, keepdims=True), s_ctx.max(-1, keepdims=True)), sink_l)
    p_loc = jnp.exp(s_loc - m)
    p_ctx = jnp.exp(s_ctx - m)
    denom = p_loc.sum(-1, keepdims=True) + p_ctx.sum(-1, keepdims=True) + jnp.exp(sink_l - m)
    o = (jnp.einsum('bnkgqj,bnjkd->bnkgqd', p_loc, vb.astype(F32))
         + jnp.einsum('bnkgqc,bckd->bnkgqd', p_ctx, v_ctx.astype(F32))) / denom
    o = o.transpose(0, 1, 4, 2, 3, 5).reshape(B, S, ATTN_WIDTH)
    return o.astype(q.dtype)


def context_attention(q, k, v, sink):
    B, C = q.shape[:2]
    scale = HEAD_DIM ** -0.5
    qc = q.reshape(B, C, N_KV_HEADS, KV_GROUP, HEAD_DIM)
    s = jnp.einsum('bqkgd,bckd->bkgqc', qc, k, preferred_element_type=F32) * scale
    sink_l = sink.astype(F32).reshape(1, N_KV_HEADS, KV_GROUP, 1, 1)
    m = jnp.maximum(s.max(-1, keepdims=True), sink_l)
    p = jnp.exp(s - m)
    denom = p.sum(-1, keepdims=True) + jnp.exp(sink_l - m)
    o = jnp.einsum('bkgqc,bckd->bkgqd', p, v.astype(F32)) / denom
    return o.transpose(0, 3, 1, 2, 4).reshape(B, C, ATTN_WIDTH).astype(q.dtype)


def multiscale_pool(p, pool_w, pool_scale):
    B, L, _ = p.shape
    p32 = p.astype(F32)
    cs = jnp.concatenate([jnp.zeros((B, 1, POOL_WIDTH), F32), jnp.cumsum(p32, axis=1)], axis=1)
    t = jnp.arange(L)
    outs = []
    for g, w in enumerate(POOL_WINDOWS):
        lo = jnp.clip(t - w // 2, 0, L)
        hi = jnp.clip(t - w // 2 + w, 0, L)
        sl = slice(g * POOL_GROUP_DIM, (g + 1) * POOL_GROUP_DIM)
        csg = cs[:, :, sl]
        mean = (csg[:, hi] - csg[:, lo]) / (hi - lo).astype(F32)[None, :, None]
        outs.append(mean - p32[:, :, sl])
    d = jnp.stack(outs, axis=2)
    y = jnp.einsum('blgc,gcd->blgd', d, pool_w.astype(F32)).reshape(B, L, POOL_WIDTH)
    return (y * pool_scale.astype(F32)).astype(p.dtype)


def routed_experts(h, idx, gate, w_gate, w_up, w_down):
    T, D = h.shape
    TK = T * TOP_K
    flat_e = idx.reshape(TK)
    flat_w = gate.reshape(TK)
    order = jnp.argsort(flat_e)
    e_sorted = flat_e[order]
    sizes = jnp.bincount(flat_e, length=N_EXPERTS)
    padded = (sizes + EXPERT_BLOCK - 1) // EXPERT_BLOCK * EXPERT_BLOCK
    pad_end = jnp.cumsum(padded)
    pad_start = pad_end - padded
    start = jnp.cumsum(sizes) - sizes
    dest = pad_start[e_sorted] + (jnp.arange(TK) - start[e_sorted])
    n_rows = -(-(TK + N_EXPERTS * (EXPERT_BLOCK - 1)) // EXPERT_BLOCK) * EXPERT_BLOCK
    n_blocks = n_rows // EXPERT_BLOCK
    row_tok = jnp.zeros((n_rows,), jnp.int32).at[dest].set((order // TOP_K).astype(jnp.int32))
    row_w = jnp.zeros((n_rows,), F32).at[dest].set(flat_w[order])
    block_e = jnp.minimum(jnp.searchsorted(pad_end, jnp.arange(n_blocks) * EXPERT_BLOCK, side='right'),
                          N_EXPERTS - 1)

    def expert_block(args):
        tok_b, w_b, e = args
        xb = h[tok_b]
        y = (jax.nn.silu(xb @ w_gate[e]) * (xb @ w_up[e])) @ w_down[e]
        return y.astype(F32) * w_b[:, None]

    y_rows = lax.map(expert_block, (row_tok.reshape(n_blocks, EXPERT_BLOCK),
                                    row_w.reshape(n_blocks, EXPERT_BLOCK), block_e))
    return jnp.zeros((T, D), F32).at[row_tok].add(y_rows.reshape(n_rows, D))


def moe_ffn(h, w_router, router_bias, w_gate, w_up, w_down, ws_gate, ws_up, ws_down):
    T = h.shape[0]
    scores = jax.nn.sigmoid(jnp.dot(h, w_router, preferred_element_type=F32))
    biased = scores + router_bias.astype(F32)
    grp_score = lax.top_k(biased.reshape(T, N_EXPERT_GROUPS, EXPERTS_PER_GROUP), 2)[0].sum(-1)
    _, top_grp = lax.top_k(grp_score, TOPK_GROUPS)
    grp_mask = jnp.any(top_grp[:, :, None] == jnp.arange(N_EXPERT_GROUPS)[None, None, :], axis=1)
    expert_mask = jnp.repeat(grp_mask, EXPERTS_PER_GROUP, axis=1)
    _, idx = lax.top_k(jnp.where(expert_mask, biased, -jnp.inf), TOP_K)
    gate = jnp.take_along_axis(scores, idx, axis=1)
    gate = gate / jnp.sum(gate, axis=-1, keepdims=True) * ROUTED_SCALE
    routed = routed_experts(h, idx, gate, w_gate, w_up, w_down)
    shared = (jax.nn.silu(h @ ws_gate) * (h @ ws_up)) @ ws_down
    return (routed + shared.astype(F32)).astype(h.dtype)


def setup_inputs(seed: int = 0) -> dict:
    key = jax.random.key(seed)
    ks = jax.random.split(key, 24)
    D, L = D_MODEL, DEPTH

    def nrm(k, shape, scale):
        return jax.random.normal(k, shape, F32) * scale

    return {
        "x": nrm(ks[0], (BATCH, SEQ, D), 1.0),
        "c": nrm(ks[1], (BATCH, D), 1.0),
        "ctx": nrm(ks[2], (BATCH, CTX_LEN, D), 1.0),
        "c_ctx": nrm(ks[3], (D,), 1.0),
        "w_ada": nrm(ks[4], (L, D, 6 * D), 0.5 * D ** -0.5),
        "b_ada": nrm(ks[5], (L, 6 * D), 0.02),
        "norm1_g": 1.0 + nrm(ks[6], (L, D), 0.05),
        "norm2_g": 1.0 + nrm(ks[7], (L, D), 0.05),
        "w_in": nrm(ks[8], (L, D, IN_COLS), D ** -0.5),
        "attn_sink": nrm(ks[9], (L, N_HEADS), 0.5),
        "pool_w": nrm(ks[10], (L, N_POOL_GROUPS, POOL_GROUP_DIM, POOL_GROUP_DIM), POOL_GROUP_DIM ** -0.5),
        "pool_scale": 1.0 + nrm(ks[11], (L, POOL_WIDTH), 0.1),
        "w_out": nrm(ks[12], (L, MIX_WIDTH, D), MIX_WIDTH ** -0.5),
        "w_router": nrm(ks[13], (L, D, N_EXPERTS), D ** -0.5),
        "router_bias": nrm(ks[14], (L, N_EXPERTS), 0.01),
        "w_gate": nrm(ks[15], (L, N_EXPERTS, D, D_EXPERT), D ** -0.5),
        "w_up": nrm(ks[16], (L, N_EXPERTS, D, D_EXPERT), D ** -0.5),
        "w_down": nrm(ks[17], (L, N_EXPERTS, D_EXPERT, D), D_EXPERT ** -0.5),
        "ws_gate": nrm(ks[18], (L, D, D_SHARED), D ** -0.5),
        "ws_up": nrm(ks[19], (L, D, D_SHARED), D ** -0.5),
        "ws_down": nrm(ks[20], (L, D_SHARED, D), D_SHARED ** -0.5),
        "final_g": 1.0 + nrm(ks[21], (D,), 0.05),
    }


def reference(x, c, ctx, c_ctx, w_ada, b_ada, norm1_g, norm2_g, w_in, attn_sink, pool_w, pool_scale,
              w_out, w_router, router_bias, w_gate, w_up, w_down, ws_gate, ws_up, ws_down, final_g):
    B, S, D = x.shape
    rope = axial_rope_tables(S)
    silu_c = jax.nn.silu(c)
    silu_cc = jax.nn.silu(c_ctx)
    for l in range(DEPTH):
        last = l == DEPTH - 1
        mod = silu_c @ w_ada[l] + b_ada[l]
        mod_c = silu_cc @ w_ada[l] + b_ada[l]
        sh1, sc1, g1, sh2, sc2, g2 = jnp.split(mod[:, None, :], 6, axis=-1)
        sh1c, sc1c, g1c, sh2c, sc2c, g2c = jnp.split(mod_c, 6)

        hx = modulate(rmsnorm(x, norm1_g[l]), sh1, sc1)
        hc = modulate(rmsnorm(ctx, norm1_g[l]), sh1c, sc1c)
        qx, kx, vx, px = split_projection(hx @ w_in[l])
        qx = apply_axial_rope(qx, rope)
        kx = apply_axial_rope(kx, rope)
        if last:
            kc, vc = split_kv(hc @ w_in[l][:, ATTN_WIDTH:ATTN_WIDTH + 2 * KV_WIDTH])
        else:
            qc, kc, vc, pc = split_projection(hc @ w_in[l])
        attn_x = latent_window_attention(qx, kx, vx, kc, vc, attn_sink[l])
        pool_x = multiscale_pool(px, pool_w[l], pool_scale[l])
        x = x + g1 * (jnp.concatenate([attn_x, pool_x], axis=-1) @ w_out[l])
        if not last:
            attn_c = context_attention(qc, kc, vc, attn_sink[l])
            pool_c = multiscale_pool(pc, pool_w[l], pool_scale[l])
            ctx = ctx + g1c * (jnp.concatenate([attn_c, pool_c], axis=-1) @ w_out[l])

        hx2 = modulate(rmsnorm(x, norm2_g[l]), sh2, sc2)
        ffn_x = moe_ffn(hx2.reshape(B * S, D), w_router[l], router_bias[l], w_gate[l], w_up[l], w_down[l],
                        ws_gate[l], ws_up[l], ws_down[l]).reshape(B, S, D)
        x = x + g2 * ffn_x
        if not last:
            Cn = ctx.shape[1]
            hc2 = modulate(rmsnorm(ctx, norm2_g[l]), sh2c, sc2c)
            ffn_c = moe_ffn(hc2.reshape(B * Cn, D), w_router[l], router_bias[l], w_gate[l], w_up[l], w_down[l],
                            ws_gate[l], ws_up[l], ws_down[l]).reshape(B, Cn, D)
            ctx = ctx + g2c * ffn_c
    return rmsnorm(x, final_g)
```

```cpp
#include <hip/hip_runtime.h>
#include <cstdio>
#include <cstdint>

#define PROBE_F(b) 0
#ifndef MK_PER_PHASE
#define MK_PER_PHASE 0
#endif

#define LAS __attribute__((address_space(3)))
typedef unsigned short bf16_t;
typedef short bf16x8 __attribute__((ext_vector_type(8)));
typedef short s16x4 __attribute__((ext_vector_type(4)));
typedef float f32x4 __attribute__((ext_vector_type(4)));
typedef unsigned u32x4 __attribute__((ext_vector_type(4)));
typedef unsigned u32x2 __attribute__((ext_vector_type(2)));
typedef float f32x2 __attribute__((ext_vector_type(2)));
typedef int i32x4 __attribute__((ext_vector_type(4)));
typedef int i32x8 __attribute__((ext_vector_type(8)));

constexpr int NB = 4, SEQ = 8192, DM = 1024, NTOK = NB * SEQ, CTXL = 256, NCTX = NB * CTXL, MROWS = NTOK + NCTX;
constexpr int NIN = 1280, NEXP = 64, NEXP1 = 65, DEXP = 256;
constexpr int NCH = 1, CH = NTOK / NCH;
constexpr float EPS = 1e-6f, LOG2E = 1.4426950408889634f;
constexpr int NWAVES = 8, NTHREADS = 512;
constexpr int NPHASE = 9;

constexpr size_t MiB = 1u << 20;
constexpr size_t WS_CTL = 0, CTL_BYTES = 1 * MiB;
constexpr size_t CTL_ADA = 8192;
constexpr size_t CTL_BAR = 16384;
constexpr size_t CTL_MOD = 65536;
constexpr size_t CTL_CNT = 262144;
constexpr size_t WS_ROPE = 1 * MiB;
constexpr size_t WS_MODF = 1 * MiB + 65536;
constexpr size_t WS_WIN = 2 * MiB;
constexpr size_t WS_WOUT = 5 * MiB;
constexpr size_t WS_WR = 7 * MiB;
constexpr size_t WS_WGU = 8 * MiB;
constexpr size_t WS_WD = 73 * MiB;
constexpr size_t WS_ASG = 106 * MiB;
constexpr size_t WS_GATE = 107 * MiB;
constexpr size_t WS_RTOK = 108 * MiB;
constexpr size_t WS_BIG = 116 * MiB;
constexpr size_t WS_HX = WS_BIG;
constexpr size_t WS_Z = WS_BIG + 66 * MiB;
constexpr size_t WS_MIX = WS_BIG + 149 * MiB;
constexpr size_t WS_H = WS_BIG;
constexpr size_t WS_Y = WS_BIG + 32 * MiB;
constexpr size_t WS_HX8 = WS_Y + (size_t)NTOK * 9 * 1024;
constexpr size_t WS_END = WS_HX8 + (size_t)NTOK * 1024;
static_assert(WS_Z + (size_t)MROWS * NIN * 2 <= WS_MIX && WS_MIX + (size_t)NTOK * DM * 2 <= 512 * MiB, "ws map");
static_assert(WS_END <= 512 * MiB, "ws map");

constexpr int STAGE_BYTES = 131072;
constexpr int L_MISC = STAGE_BYTES;
constexpr int L_TB = L_MISC + 128;
constexpr int L_CNT = L_TB + 66 * 4 + 8;
constexpr int L_YB = L_CNT + 65 * 4 + 12;
constexpr int L_HIST = L_YB + 65 * 4 + 12;
constexpr int L_BASE = L_HIST + 256;
constexpr int L_PTR = L_BASE + 256;
constexpr int LDS_BYTES = STAGE_BYTES + 4096;
static_assert(L_PTR + 256 <= LDS_BYTES, "lds map");

__device__ __forceinline__ unsigned cvt_pk_bf16(float lo, float hi) { unsigned r; asm volatile("v_cvt_pk_bf16_f32 %0, %1, %2" : "=v"(r) : "v"(lo), "v"(hi)); return r; }
__device__ __forceinline__ float bf_lo(unsigned w) { return __uint_as_float(w << 16); }
__device__ __forceinline__ float bf_hi(unsigned w) { return __uint_as_float(w & 0xffff0000u); }
__device__ __forceinline__ float wave_sum(float v) {
#pragma unroll
    for (int o = 1; o < 64; o <<= 1) v += __shfl_xor(v, o);
    return v;
}
__device__ __forceinline__ int invperm32(int p) { return 16 * ((p >> 2) & 1) + 4 * (p >> 3) + (p & 3); }
__device__ __forceinline__ float quad_allmax(float x) {
    const auto r = __builtin_amdgcn_permlane16_swap(__float_as_uint(x), __float_as_uint(x), false, false);
    x = fmaxf(__uint_as_float(r[0]), __uint_as_float(r[1]));
    const auto q = __builtin_amdgcn_permlane32_swap(__float_as_uint(x), __float_as_uint(x), false, false);
    return fmaxf(__uint_as_float(q[0]), __uint_as_float(q[1]));
}
__device__ __forceinline__ float quad_allsum(float x) {
    const auto r = __builtin_amdgcn_permlane16_swap(__float_as_uint(x), __float_as_uint(x), false, false);
    x = __uint_as_float(r[0]) + __uint_as_float(r[1]);
    const auto q = __builtin_amdgcn_permlane32_swap(__float_as_uint(x), __float_as_uint(x), false, false);
    return __uint_as_float(q[0]) + __uint_as_float(q[1]);
}
#define LDS_WAIT() asm volatile("s_waitcnt lgkmcnt(0)" ::: "memory")
#define VM_WAIT() asm volatile("s_waitcnt vmcnt(0)" ::: "memory")

#define XB_TMO      128
#define XB_XCNT(j)  (256  + 64 * (j))
#define XB_XSUB(j)  (1280 + 64 * (j))
#define XB_XGEN(j)  (2304 + 64 * (j))
#define XB_TOP      3328
#define XB_TOPGEN   3392
#define XCD_BAR_WORDS 3456
#define XB_SPIN_CAP (1u << 18)
__device__ __forceinline__ unsigned xb_ld(unsigned* p)              { return __hip_atomic_load(p, __ATOMIC_RELAXED, __HIP_MEMORY_SCOPE_AGENT); }
__device__ __forceinline__ unsigned xb_add(unsigned* p, unsigned v) { return __hip_atomic_fetch_add(p, v, __ATOMIC_RELAXED, __HIP_MEMORY_SCOPE_AGENT); }
__device__ __forceinline__ unsigned xb_xcc_id() { return (unsigned)__builtin_amdgcn_s_getreg((3 << 11) | 20) & 0xFu; }
#define XB_SPIN(cond, bar) do { unsigned _sp = 0; while (cond) { __builtin_amdgcn_s_sleep(1); \
    if ((++_sp & 255u) == 0u) { if (xb_ld(&(bar)[XB_TMO])) break; if (_sp > XB_SPIN_CAP) { atomicAdd(&(bar)[XB_TMO], 1u); break; } } } } while (0)
struct XcdBarrier { unsigned* bar; unsigned x; volatile LAS unsigned* st; };
__device__ __forceinline__ XcdBarrier xcd_barrier_post(unsigned* bar, volatile LAS unsigned* st) {
    XcdBarrier b; b.bar = bar; b.x = xb_xcc_id(); b.st = st;
    if (threadIdx.x == 0) (void)xb_add(&bar[XB_XCNT(b.x)], 1u);
    return b;
}
__device__ __forceinline__ void xcd_barrier_complete(unsigned* bar, unsigned x, unsigned& nloc, unsigned& nx) {
    const unsigned G = gridDim.x * gridDim.y * gridDim.z;
    unsigned sum, cnt, mine, sp = 0u;
    for (;;) {
        sum = 0u; cnt = 0u; mine = 0u;
#pragma unroll
        for (unsigned j = 0; j < 16; ++j) { const unsigned c = xb_ld(&bar[XB_XCNT(j)]); sum += c; cnt += (c > 0u) ? 1u : 0u; mine = (j == x) ? c : mine; }
        if (sum == G) break;
        __builtin_amdgcn_s_sleep(1);
        if ((++sp & 255u) == 0u) { if (xb_ld(&bar[XB_TMO])) break; if (sp > XB_SPIN_CAP) { atomicAdd(&bar[XB_TMO], 1u); break; } }
    }
    nloc = mine > 0u ? mine : 1u; nx = cnt > 0u ? cnt : 1u;
}
__device__ __forceinline__ void xcd_barrier(const XcdBarrier& b) {
    asm volatile("s_waitcnt vmcnt(0)" ::: "memory");
    __syncthreads();
    if (threadIdx.x == 0) {
        unsigned* bar = b.bar;
        __builtin_amdgcn_s_waitcnt(0);
        unsigned nloc = b.st[0], nx = b.st[1];
        if (nloc == 0u) { xcd_barrier_complete(bar, b.x, nloc, nx); b.st[0] = nloc; b.st[1] = nx; }
        const unsigned old = xb_add(&bar[XB_XSUB(b.x)], 1u);
        const unsigned gen = old / nloc;
        if (old + 1u == (gen + 1u) * nloc) {
            __builtin_amdgcn_fence(__ATOMIC_RELEASE, "agent");
            asm volatile("s_waitcnt vmcnt(0)" ::: "memory");
            const unsigned og = xb_add(&bar[XB_TOP], 1u);
            const unsigned tg = og / nx;
            if (og + 1u == (tg + 1u) * nx) xb_add(&bar[XB_TOPGEN], 1u);
            else XB_SPIN(xb_ld(&bar[XB_TOPGEN]) == tg, bar);
            __builtin_amdgcn_fence(__ATOMIC_ACQUIRE, "agent");
            xb_add(&bar[XB_XGEN(b.x)], 1u);
            asm volatile("s_waitcnt vmcnt(0)" ::: "memory");
        } else {
            XB_SPIN(xb_ld(&bar[XB_XGEN(b.x)]) == gen, bar);
            __builtin_amdgcn_fence(__ATOMIC_ACQUIRE, "agent");
            asm volatile("s_waitcnt vmcnt(0)" ::: "memory");
        }
    }
    __syncthreads();
}

namespace pg8 {
constexpr int BM = 256, BK = 64, HALF = 128, HTB = HALF * BK * 2, NXCD = 8, WGM = 8;
__device__ __forceinline__ int lds_byte(int r, int c) { const int st = (r >> 4) * 2 + (c >> 5), rr = r & 15, cc = c & 31, ob = rr * 64 + cc * 2; return st * 1024 + (ob ^ (((ob >> 9) & 1) << 5)); }
__device__ __forceinline__ void stage_rc(int b, int& R, int& C) { const int st = b / 1024, sb = b % 1024, swz = sb ^ (((sb >> 9) & 1) << 5); R = (st >> 1) * 16 + swz / 64; C = (st & 1) * 32 + (swz % 64) / 2; }
struct Unit { int pm, pn, e, j; };

struct SchedStatic {
    int nM, nN, nwg, G, c, extra, extra_pn; const char* A; const char* Bt; int K;
    __device__ __forceinline__ bool next(int i, Unit& u) const {
        const int L = i * G + c; u.e = 0; u.j = 0;
        if (L >= nwg) { if (L >= nwg + extra) return false; u.pm = nM + (L - nwg); u.pn = extra_pn; return true; }
        int wgid = L; { const int q = nwg / NXCD, r = nwg % NXCD, xcd = wgid % NXCD, off = wgid / NXCD; wgid = (xcd < r ? xcd * (q + 1) : r * (q + 1) + (xcd - r) * q) + off; }
        const int nig = WGM * nN, gid = wgid / nig, fm = gid * WGM, gsz = (nM - fm) < WGM ? (nM - fm) : WGM;
        u.pm = fm + ((wgid % nig) % gsz); u.pn = (wgid % nig) / gsz; return true;
    }
    __device__ __forceinline__ const char* a_ptr(const Unit& u) const { return A + (size_t)u.pm * (size_t)(BM * 2) * K; }
    __device__ __forceinline__ const char* b_ptr(const Unit& u) const { return Bt + (size_t)u.pn * (size_t)(BM * 2) * K; }
    __device__ __forceinline__ unsigned a_off(const Unit&, int) const { return 0u; }
};
struct SchedTile {
    const LAS int* cnt; int e, j, nN; const char* A; const char* Bt; size_t bstride; int K;
    const int* rtok; int tok0;
    unsigned arow, aofs;
    __device__ __forceinline__ bool next(int i, Unit& u) const { if (i >= nN) return false; u.e = e; u.j = j; u.pm = 0; u.pn = i; return true; }
    __device__ __forceinline__ const char* a_ptr(const Unit&) const { return A; }
    __device__ __forceinline__ const char* b_ptr(const Unit& u) const { return Bt + (size_t)u.e * bstride + (size_t)u.pn * (size_t)(BM * 2) * K; }
    __device__ __forceinline__ unsigned a_off(const Unit& u, int r) const {
        int slot = u.j * BM + r; const int n = cnt[u.e]; slot = slot < n ? slot : n - 1;
        const int tok = (u.e < NEXP) ? rtok[(size_t)u.e * CH + slot] : tok0 + slot;
        return (unsigned)tok * arow + aofs;
    }
};

template <class Epi, class Sched, bool GATHER, bool FP8 = false>
__device__ __forceinline__ void gemm_phase(LAS unsigned char* lds, const Sched& S, const Epi& E) {
    int tid = threadIdx.x; asm volatile("" : "+v"(tid));
    const int wid = __builtin_amdgcn_readfirstlane(tid >> 6), lane = tid & 63, wr = wid >> 2, wc = wid & 3, fr = lane & 15, fq = lane >> 4;
    const int K = S.K, nt = K / BK;
    unsigned voffA[2], voffB[2]; int RA[2], CA[2];
#pragma unroll
    for (int i = 0; i < 2; ++i) { int R, C; stage_rc(tid * 16 + i * 8192, R, C); RA[i] = R; CA[i] = C; voffA[i] = (unsigned)(R * K + C) * 2u; voffB[i] = (unsigned)(R * K + C) * 2u; }
    const size_t kstep = (size_t)(BK * 2);
    const size_t hstep = (size_t)HALF * K * 2;
    const unsigned ldsw = (unsigned)wid * 1024u;
    const int aoff = lds_byte(wr * 64 + fr, fq * 8), boff = lds_byte(wc * 32 + fr, fq * 8);
    unsigned gv[2][2];
#define PG8_SA(b, h) (((b) * 2 + (h)) * HTB)
#define PG8_SB(b, h) ((4 + (b) * 2 + (h)) * HTB)
#define PG8_STAGE(bufoff, gbase, voff) do { _Pragma("unroll") for (int _i = 0; _i < 2; ++_i) \
        __builtin_amdgcn_global_load_lds((const unsigned*)((const char*)(gbase) + (voff)[_i]), (LAS unsigned*)(lds + (bufoff) + ldsw + _i * 8192), 16, 0, 0); } while (0)
#define PG8_STAGE_A(bufoff, h, p) do { if constexpr (GATHER) { PG8_STAGE(bufoff, p, gv[h]); } else { PG8_STAGE(bufoff, (p) + (h) * hstep, voffA); } } while (0)
#define PG8_LDA(dst, b, h) do { _Pragma("unroll") for (int m = 0; m < 4; ++m) _Pragma("unroll") for (int k = 0; k < 2; ++k) dst[m][k] = *(const LAS bf16x8*)(lds + PG8_SA(b, h) + aoff + m * 2048 + k * 1024); } while (0)
#define PG8_LDB(dst, b, h) do { _Pragma("unroll") for (int n = 0; n < 2; ++n) _Pragma("unroll") for (int k = 0; k < 2; ++k) dst[n][k] = *(const LAS bf16x8*)(lds + PG8_SB(b, h) + boff + n * 2048 + k * 1024); } while (0)
#define PG8_MMA(ai, bj, At, Bt) do { __builtin_amdgcn_s_setprio(1); _Pragma("unroll") for (int m = 0; m < 4; ++m) _Pragma("unroll") for (int n = 0; n < 2; ++n) { \
        if constexpr (FP8) { const i32x8 b8_ = __builtin_shufflevector(__builtin_bit_cast(i32x4, Bt[n][0]), __builtin_bit_cast(i32x4, Bt[n][1]), 0, 1, 2, 3, 4, 5, 6, 7); \
                             const i32x8 a8_ = __builtin_shufflevector(__builtin_bit_cast(i32x4, At[m][0]), __builtin_bit_cast(i32x4, At[m][1]), 0, 1, 2, 3, 4, 5, 6, 7); \
                             acc[ai][bj][m][n] = __builtin_amdgcn_mfma_scale_f32_16x16x128_f8f6f4(b8_, a8_, acc[ai][bj][m][n], 0, 0, 0, 127, 0, 127); } \
        else { _Pragma("unroll") for (int k = 0; k < 2; ++k) acc[ai][bj][m][n] = __builtin_amdgcn_mfma_f32_16x16x32_bf16(Bt[n][k], At[m][k], acc[ai][bj][m][n], 0, 0, 0); } } \
        __builtin_amdgcn_s_setprio(0); } while (0)
#define PG8_WAIT_V(n) asm volatile("s_waitcnt vmcnt(" #n ")" ::: "memory")
#define PG8_WAIT_L(n) asm volatile("s_waitcnt lgkmcnt(" #n ")" ::: "memory")
#define PG8_BAR __builtin_amdgcn_s_barrier()
#define PG8_SCHED __builtin_amdgcn_sched_barrier(0)
#define PG8_GOFF(dst, u) do { _Pragma("unroll") for (int _h = 0; _h < 2; ++_h) _Pragma("unroll") for (int _i = 0; _i < 2; ++_i) dst[_h][_i] = S.a_off(u, _h * HALF + RA[_i]) + (unsigned)CA[_i] * 2u; } while (0)
    Unit cur, nxt; int ui = 0;
    if (!S.next(0, cur)) return;
    f32x4 acc[2][2][4][2];
#pragma unroll
    for (int a = 0; a < 2; ++a)
#pragma unroll
        for (int b = 0; b < 2; ++b)
#pragma unroll
            for (int m = 0; m < 4; ++m)
#pragma unroll
                for (int n = 0; n < 2; ++n) acc[a][b][m][n] = (f32x4){0.f, 0.f, 0.f, 0.f};
    bf16x8 At[4][2], B0[2][2], B1[2][2];
    const char* cA = GATHER ? S.A : S.a_ptr(cur); const char* cB = S.b_ptr(cur);
    if constexpr (GATHER) PG8_GOFF(gv, cur);
    PG8_STAGE(PG8_SB(0, 0), cB, voffB); PG8_STAGE_A(PG8_SA(0, 0), 0, cA); PG8_STAGE(PG8_SB(0, 1), cB + hstep, voffB); PG8_STAGE_A(PG8_SA(0, 1), 1, cA);
    if (wr == 1) PG8_BAR;
    PG8_WAIT_V(4); PG8_BAR;
    PG8_STAGE(PG8_SB(1, 0), cB + kstep, voffB); PG8_STAGE_A(PG8_SA(1, 0), 0, cA + kstep); PG8_STAGE(PG8_SB(1, 1), cB + hstep + kstep, voffB);
    PG8_WAIT_V(6); PG8_BAR;
    for (;;) {
        const bool has_next = S.next(ui + 1, nxt);
        const char* nA = GATHER ? S.A : (has_next ? S.a_ptr(nxt) : cA); const char* nB = has_next ? S.b_ptr(nxt) : cB;
        for (int t = 0; t < nt; t += 2) {
            const bool last = (t == nt - 2);
            const char* a1 = cA + (size_t)(t + 1) * kstep;
            const char* a2 = last ? nA : cA + (size_t)(t + 2) * kstep; const char* b2 = last ? nB : cB + (size_t)(t + 2) * kstep;
            const char* a3 = a2 + kstep; const char* b3 = b2 + kstep;
            unsigned nv[2][2];
            if constexpr (GATHER) { if (last && has_next) PG8_GOFF(nv, nxt); }
            PG8_LDB(B0, 0, 0); PG8_SCHED; PG8_LDA(At, 0, 0); PG8_STAGE_A(PG8_SA(1, 1), 1, a1);
            if constexpr (GATHER) { if (last && has_next) { gv[0][0] = nv[0][0]; gv[0][1] = nv[0][1]; gv[1][0] = nv[1][0]; gv[1][1] = nv[1][1]; } }
            PG8_WAIT_L(8); PG8_BAR; PG8_WAIT_L(0); PG8_MMA(0, 0, At, B0); PG8_BAR; PG8_SCHED;
            PG8_LDB(B1, 0, 1); PG8_STAGE(PG8_SB(0, 0), b2, voffB);
            PG8_BAR; PG8_WAIT_L(0); PG8_MMA(0, 1, At, B1); PG8_BAR;
            PG8_LDA(At, 0, 1); PG8_STAGE_A(PG8_SA(0, 0), 0, a2);
            PG8_BAR; PG8_WAIT_L(0); PG8_MMA(1, 0, At, B0); PG8_BAR; PG8_SCHED;
            PG8_STAGE(PG8_SB(0, 1), b2 + hstep, voffB);
            PG8_WAIT_V(6); PG8_BAR; PG8_MMA(1, 1, At, B1); PG8_BAR;
            PG8_LDB(B0, 1, 0); PG8_SCHED; PG8_LDA(At, 1, 0); PG8_STAGE_A(PG8_SA(0, 1), 1, a2);
            PG8_WAIT_L(8); PG8_BAR; PG8_WAIT_L(0); PG8_MMA(0, 0, At, B0); PG8_BAR; PG8_SCHED;
            PG8_LDB(B1, 1, 1); PG8_STAGE(PG8_SB(1, 0), b3, voffB);
            PG8_BAR; PG8_WAIT_L(0); PG8_MMA(0, 1, At, B1); PG8_BAR;
            PG8_LDA(At, 1, 1); PG8_STAGE_A(PG8_SA(1, 0), 0, a3);
            PG8_BAR; PG8_WAIT_L(0); PG8_MMA(1, 0, At, B0); PG8_BAR; PG8_SCHED;
            PG8_STAGE(PG8_SB(1, 1), b3 + hstep, voffB);
            PG8_WAIT_V(6); PG8_BAR; PG8_MMA(1, 1, At, B1); PG8_BAR;
        }
        E(acc, cur, wr, wc, fr, fq);
        if (!has_next) break;
#pragma unroll
        for (int a = 0; a < 2; ++a)
#pragma unroll
            for (int b = 0; b < 2; ++b)
#pragma unroll
                for (int m = 0; m < 4; ++m)
#pragma unroll
                    for (int n = 0; n < 2; ++n) acc[a][b][m][n] = (f32x4){0.f, 0.f, 0.f, 0.f};
        cur = nxt; cA = nA; cB = nB; ++ui;
    }
    PG8_WAIT_V(0);
    if (wr == 0) PG8_BAR;
    PG8_BAR;
#undef PG8_SA
#undef PG8_SB
#undef PG8_STAGE
#undef PG8_STAGE_A
#undef PG8_LDA
#undef PG8_LDB
#undef PG8_MMA
#undef PG8_WAIT_V
#undef PG8_WAIT_L
#undef PG8_BAR
#undef PG8_SCHED
#undef PG8_GOFF
}
}

struct EpiIn {
    bf16_t* z; const float* cosT; const float* sinT;
    __device__ __forceinline__ void operator()(const f32x4 (&acc)[2][2][4][2], const pg8::Unit& u, int wr, int wc, int fr, int fq) const {
        const bool is_x = u.pm < NTOK / 256, anyrope = is_x && u.pn <= 2;
        f32x4 cs[2][4], sn[2][4];
#pragma unroll
        for (int ai = 0; ai < 2; ++ai)
#pragma unroll
            for (int m = 0; m < 4; ++m) {
                const int row = u.pm * 256 + ai * 128 + wr * 64 + m * 16 + fr, s = row & (SEQ - 1), pos = (wc & 1) ? (s & 63) : (s >> 6);
                cs[ai][m] = (f32x4){1.f, 1.f, 1.f, 1.f}; sn[ai][m] = (f32x4){0.f, 0.f, 0.f, 0.f};
                if (anyrope) { cs[ai][m] = *(const f32x4*)(cosT + pos * 16 + 4 * fq); sn[ai][m] = *(const f32x4*)(sinT + pos * 16 + 4 * fq); } }
        asm volatile("" ::: "memory");
#pragma unroll
        for (int ai = 0; ai < 2; ++ai)
#pragma unroll
            for (int m = 0; m < 4; ++m) {
                const int row = u.pm * 256 + ai * 128 + wr * 64 + m * 16 + fr;
                bf16_t* rowp = z + (size_t)row * NIN + u.pn * 256 + wc * 32 + 8 * fq;
#pragma unroll
                for (int bj = 0; bj < 2; ++bj) {
                    const bool rope = is_x && (u.pn < 2 || (u.pn == 2 && bj == 0));
                    const float sc = (u.pn < 2) ? 0.125f * LOG2E : 1.0f;
                    f32x4 v0 = acc[ai][bj][m][0], v1 = acc[ai][bj][m][1];
                    if (rope) { const f32x4 o0 = v0 * cs[ai][m] - v1 * sn[ai][m], o1 = v0 * sn[ai][m] + v1 * cs[ai][m]; v0 = o0; v1 = o1; }
                    v0 = v0 * sc; v1 = v1 * sc;
                    u32x4 w; w.x = cvt_pk_bf16(v0[0], v0[1]); w.y = cvt_pk_bf16(v0[2], v0[3]); w.z = cvt_pk_bf16(v1[0], v1[1]); w.w = cvt_pk_bf16(v1[2], v1[3]);
                    *(u32x4*)(rowp + bj * 128) = w;
                }
            }
    }
};
struct EpiOut {
    const float* x; const float* modf; unsigned char* outb;
    __device__ __forceinline__ void operator()(const f32x4 (&acc)[2][2][4][2], const pg8::Unit& u, int wr, int wc, int fr, int fq) const {
        const int b = (u.pm * 256) / SEQ, col0 = u.pn * 256 + wc * 32 + 8 * fq;
        const float* g1 = modf + b * 6144 + 2 * DM + col0;
        f32x4 gv[2][2];
#pragma unroll
        for (int bj = 0; bj < 2; ++bj) { gv[bj][0] = *(const f32x4*)(g1 + bj * 128); gv[bj][1] = *(const f32x4*)(g1 + bj * 128 + 4); }
#pragma unroll
        for (int ai = 0; ai < 2; ++ai) {
            f32x4 xv[4][2][2];
#pragma unroll
            for (int m = 0; m < 4; ++m)
#pragma unroll
                for (int bj = 0; bj < 2; ++bj) { const float* xr = x + (size_t)(u.pm * 256 + ai * 128 + wr * 64 + m * 16 + fr) * DM + col0 + bj * 128;
                    xv[m][bj][0] = *(const f32x4*)xr; xv[m][bj][1] = *(const f32x4*)(xr + 4); }
            asm volatile("" ::: "memory");
#pragma unroll
            for (int m = 0; m < 4; ++m) {
                const int row = u.pm * 256 + ai * 128 + wr * 64 + m * 16 + fr;
#pragma unroll
                for (int bj = 0; bj < 2; ++bj) {
                    const f32x4 v0 = xv[m][bj][0] + gv[bj][0] * acc[ai][bj][m][0], v1 = xv[m][bj][1] + gv[bj][1] * acc[ai][bj][m][1];
                    u32x4 w; w.x = cvt_pk_bf16(v0[0], v0[1]); w.y = cvt_pk_bf16(v0[2], v0[3]); w.z = cvt_pk_bf16(v1[0], v1[1]); w.w = cvt_pk_bf16(v1[2], v1[3]);
                    *(u32x4*)(outb + (size_t)row * 4096 + (size_t)(col0 + bj * 128) * 2) = w;
                }
            }
            asm volatile("" ::: "memory");
        }
    }
};
struct EpiGU {
    unsigned char* H; int skip;
    __device__ __forceinline__ void operator()(const f32x4 (&acc)[2][2][4][2], const pg8::Unit& u, int wr, int wc, int fr, int fq) const {
        if (skip) return;
#pragma unroll
        for (int ai = 0; ai < 2; ++ai)
#pragma unroll
            for (int m = 0; m < 4; ++m) {
                const size_t row = (size_t)u.pm * 256 + ai * 128 + wr * 64 + m * 16 + fr;
                float h[8];
#pragma unroll
                for (int n = 0; n < 2; ++n)
#pragma unroll
                    for (int j = 0; j < 4; j += 2) {
                        const f32x2 g = (f32x2){acc[ai][0][m][n][j], acc[ai][0][m][n][j + 1]}, up = (f32x2){acc[ai][1][m][n][j], acc[ai][1][m][n][j + 1]};
                        const f32x2 t = g * (-LOG2E / 32.0f); f32x2 e; e.x = __builtin_amdgcn_exp2f(t.x); e.y = __builtin_amdgcn_exp2f(t.y);
                        const f32x2 d = e + 1.0f; f32x2 r; r.x = __builtin_amdgcn_rcpf(d.x); r.y = __builtin_amdgcn_rcpf(d.y);
                        const f32x2 hh = (g * up) * (r * (1.0f / 1024.0f));
                        h[n * 4 + j] = hh.x; h[n * 4 + j + 1] = hh.y; }
                u32x2 w; int pk = 0;
                pk = __builtin_amdgcn_cvt_pk_fp8_f32(h[0], h[1], pk, false); pk = __builtin_amdgcn_cvt_pk_fp8_f32(h[2], h[3], pk, true); w.x = (unsigned)pk;
                pk = __builtin_amdgcn_cvt_pk_fp8_f32(h[4], h[5], pk, false); pk = __builtin_amdgcn_cvt_pk_fp8_f32(h[6], h[7], pk, true); w.y = (unsigned)pk;
                *(u32x2*)(H + row * DEXP + u.pn * 128 + wc * 32 + 8 * fq) = w;
            }
    }
};
struct EpiD {
    unsigned char* Y; const LAS int* cnt; const LAS int* yb; int skip;
    __device__ __forceinline__ void operator()(const f32x4 (&acc)[2][2][4][2], const pg8::Unit& u, int wr, int wc, int fr, int fq) const {
        if (skip) return;
        const int n = cnt[u.e], y0 = yb[u.e];
#pragma unroll
        for (int ai = 0; ai < 2; ++ai)
#pragma unroll
            for (int m = 0; m < 4; ++m) {
                const int slot = u.j * 256 + ai * 128 + wr * 64 + m * 16 + fr;
                if (slot < n) {
                    u32x4 w;
#pragma unroll
                    for (int bj = 0; bj < 2; ++bj)
#pragma unroll
                        for (int nn = 0; nn < 2; ++nn) { f32x4 v = acc[ai][bj][m][nn];
                            int pk = 0; pk = __builtin_amdgcn_cvt_pk_fp8_f32(v[0], v[1], pk, false); pk = __builtin_amdgcn_cvt_pk_fp8_f32(v[2], v[3], pk, true); w[2 * bj + nn] = (unsigned)pk; }
                    *(u32x4*)(Y + (size_t)(y0 + slot) * DM + u.pn * 256 + wc * 64 + 16 * fq) = w;
                }
            }
    }
};


__device__ __forceinline__ void moe_down_tile(LAS unsigned char* lds, const unsigned char* Hblk, const unsigned char* Wd, unsigned char* Y, unsigned char* dumprow, int y0, int n, int j) {
    int tid = threadIdx.x; asm volatile("" : "+v"(tid));
    const int w = __builtin_amdgcn_readfirstlane(tid >> 6), lane = tid & 63, fr = lane & 15, fq = lane >> 4;
    const unsigned lds0 = (unsigned)(size_t)lds;
    i32x8 b8[8][2];
    { const unsigned char* const bp = Wd + (size_t)(w * 128 + fr) * 256 + fq * 32;
#pragma unroll
      for (int cb = 0; cb < 8; ++cb)
#pragma unroll
          for (int ks = 0; ks < 2; ++ks) { const unsigned char* p = bp + cb * 4096 + ks * 128; b8[cb][ks] = __builtin_shufflevector(*(const i32x4*)p, *(const i32x4*)(p + 16), 0, 1, 2, 3, 4, 5, 6, 7); } }
    asm volatile("" ::: "memory");
    { const unsigned char* const hsrc = Hblk + w * 8192;
#pragma unroll
      for (int i = 0; i < 8; ++i) __builtin_amdgcn_global_load_lds((const unsigned*)(hsrc + i * 1024 + (unsigned)(fq * 256 + ((fr ^ (4 * (i & 3) + fq)) << 4))), (LAS unsigned*)(lds + w * 8192 + i * 1024), 16, 0, 0); }
    const unsigned x00 = (unsigned)(((2 * fq) ^ fr) << 4), rb_ = lds0 + (unsigned)fr * 256u;
    const unsigned la0 = rb_ + x00, la1 = rb_ + (x00 ^ 16u), la2 = rb_ + (x00 ^ 128u), la3 = rb_ + (x00 ^ 144u);
    unsigned char* const ycol = Y + (size_t)y0 * DM + w * 128 + fq * 32;
    unsigned char* const dcol = dumprow + w * 128 + fq * 32;
    const int slot0 = j * 256 + fr;
    asm volatile("s_waitcnt vmcnt(0)" ::: "memory"); __builtin_amdgcn_s_barrier();
#define D2_RD(F, rb) do { const unsigned o_ = (unsigned)(rb) * 4096u; \
        asm volatile("ds_read_b128 %0, %4\n\tds_read_b128 %1, %5\n\tds_read_b128 %2, %6\n\tds_read_b128 %3, %7" \
                     : "=&v"(F[0]), "=&v"(F[1]), "=&v"(F[2]), "=&v"(F[3]) : "v"(la0 + o_), "v"(la1 + o_), "v"(la2 + o_), "v"(la3 + o_) : "memory"); __builtin_amdgcn_sched_barrier(0); } while (0)
#define D2_LW(F) __builtin_amdgcn_sched_barrier(0); asm volatile("s_waitcnt lgkmcnt(0)" : "+v"(F[0]), "+v"(F[1]), "+v"(F[2]), "+v"(F[3]) :: "memory")
#define D2_MM(ACC, F) do { const i32x8 a0_ = __builtin_shufflevector(F[0], F[1], 0, 1, 2, 3, 4, 5, 6, 7), a1_ = __builtin_shufflevector(F[2], F[3], 0, 1, 2, 3, 4, 5, 6, 7); \
        _Pragma("unroll") for (int cb = 0; cb < 8; ++cb) ACC[cb] = __builtin_amdgcn_mfma_scale_f32_16x16x128_f8f6f4(b8[cb][0], a0_, (f32x4){0.f, 0.f, 0.f, 0.f}, 0, 0, 0, 127, 0, 127); \
        _Pragma("unroll") for (int cb = 0; cb < 8; ++cb) ACC[cb] = __builtin_amdgcn_mfma_scale_f32_16x16x128_f8f6f4(b8[cb][1], a1_, ACC[cb], 0, 0, 0, 127, 0, 127); } while (0)
#define D2_E(rb, ACC) do { const int slot_ = slot0 + (rb) * 16; unsigned char* const p_ = slot_ < n ? ycol + (size_t)slot_ * DM : dcol; u32x4 w0_, w1_; \
        _Pragma("unroll") for (int cb = 0; cb < 4; ++cb) { const f32x4 v_ = ACC[cb]; int pk_ = 0; pk_ = __builtin_amdgcn_cvt_pk_fp8_f32(v_[0], v_[1], pk_, false); pk_ = __builtin_amdgcn_cvt_pk_fp8_f32(v_[2], v_[3], pk_, true); w0_[cb] = (unsigned)pk_; } \
        _Pragma("unroll") for (int cb = 0; cb < 4; ++cb) { const f32x4 v_ = ACC[4 + cb]; int pk_ = 0; pk_ = __builtin_amdgcn_cvt_pk_fp8_f32(v_[0], v_[1], pk_, false); pk_ = __builtin_amdgcn_cvt_pk_fp8_f32(v_[2], v_[3], pk_, true); w1_[cb] = (unsigned)pk_; } \
        *(u32x4*)p_ = w0_; *(u32x4*)(p_ + 16) = w1_; } while (0)
    f32x4 accP[8], accQ[8];
    i32x4 A0[4], A1[4];
    D2_RD(A0, 0); D2_LW(A0);
    D2_RD(A1, 1); D2_MM(accP, A0); D2_LW(A1);
#pragma nounroll
    for (int rb = 0; rb < 14; rb += 2) {
        D2_RD(A0, rb + 2); D2_MM(accQ, A1); D2_E(rb, accP); D2_LW(A0);
        D2_RD(A1, rb + 3); D2_MM(accP, A0); D2_E(rb + 1, accQ); D2_LW(A1);
    }
    D2_MM(accQ, A1); D2_E(14, accP);
    __builtin_amdgcn_s_barrier();
    D2_E(15, accQ);
#undef D2_RD
#undef D2_LW
#undef D2_MM
#undef D2_E
}

struct Args { const float* in[22]; float* out; unsigned char* ws; int ph_lo, ph_hi; };

__device__ __forceinline__ int mapd64(int c) { const int p = c & 127; return (c & ~127) + 16 * ((p >> 2) & 7) + 4 * (p >> 5) + (p & 3); }
__device__ __forceinline__ int map16(int p) { return 128 * ((p >> 3) & 1) + 16 * ((p >> 2) & 1) + 4 * ((p >> 4) & 1) + (p & 3); }
__device__ __forceinline__ void transpose_item(const float* W, int ldw, int k0, int n0, bf16_t* dst, int ldd, int rowbase, int perm, LAS float* scr, int lane, float wscale = 1.0f) {
    f32x4 v[8];
#pragma unroll
    for (int i = 0; i < 8; ++i) v[i] = *(const f32x4*)(W + (size_t)(k0 + 8 * i + (lane >> 3)) * ldw + n0 + 4 * (lane & 7));
#pragma unroll
    for (int i = 0; i < 8; ++i) { LAS float* d = scr + (8 * i + (lane >> 3)) * 33 + 4 * (lane & 7); d[0] = v[i][0] * wscale; d[1] = v[i][1] * wscale; d[2] = v[i][2] * wscale; d[3] = v[i][3] * wscale; }
    LDS_WAIT();
    const int c = lane & 7;
#pragma unroll
    for (int j = 0; j < 4; ++j) { const int n = (lane >> 3) + 8 * j; const LAS float* s = scr + (8 * c) * 33 + n;
        u32x4 o; o.x = cvt_pk_bf16(s[0 * 33], s[1 * 33]); o.y = cvt_pk_bf16(s[2 * 33], s[3 * 33]); o.z = cvt_pk_bf16(s[4 * 33], s[5 * 33]); o.w = cvt_pk_bf16(s[6 * 33], s[7 * 33]);
        const int drow = rowbase + (perm == 2 ? map16(n) : (perm ? invperm32(n) : n));
        *(u32x4*)(dst + (size_t)drow * ldd + k0 + 8 * c) = o; }
    LDS_WAIT();
}

__device__ __forceinline__ void transpose_item8(const float* W, int ldw, int k0, int n0, unsigned char* dst, int ldd, int rowbase, int perm, LAS float* scr, int lane, float wscale) {
    f32x4 v[8];
#pragma unroll
    for (int i = 0; i < 8; ++i) v[i] = *(const f32x4*)(W + (size_t)(k0 + 8 * i + (lane >> 3)) * ldw + n0 + 4 * (lane & 7));
#pragma unroll
    for (int i = 0; i < 8; ++i) { LAS float* d = scr + (8 * i + (lane >> 3)) * 33 + 4 * (lane & 7); d[0] = v[i][0] * wscale; d[1] = v[i][1] * wscale; d[2] = v[i][2] * wscale; d[3] = v[i][3] * wscale; }
    LDS_WAIT();
    const int c4 = lane & 3;
#pragma unroll
    for (int j = 0; j < 2; ++j) { const int n = (lane >> 2) + 16 * j; const LAS float* sp = scr + (16 * c4) * 33 + n;
        u32x4 o;
#pragma unroll
        for (int q = 0; q < 4; ++q) { int pk = 0;
            pk = __builtin_amdgcn_cvt_pk_fp8_f32(sp[(4 * q + 0) * 33], sp[(4 * q + 1) * 33], pk, false);
            pk = __builtin_amdgcn_cvt_pk_fp8_f32(sp[(4 * q + 2) * 33], sp[(4 * q + 3) * 33], pk, true);
            o[q] = (unsigned)pk; }
        const int drow = perm == 3 ? mapd64(rowbase + n) : rowbase + (perm == 2 ? map16(n) : (perm ? invperm32(n) : n));
        *(u32x4*)(dst + (size_t)drow * ldd + k0 + 16 * c4) = o; }
    LDS_WAIT();
}

template <int W> __device__ __forceinline__ void pool4(const bf16_t* zp, int s, bf16_t* op) {
    u32x4 row[W + 3];
#pragma unroll
    for (int j = 0; j < W + 3; ++j) { const int s2 = s - W / 2 + j; const bool ok = s2 >= 0 && s2 < SEQ; row[j] = ok ? *(const u32x4*)(zp + (size_t)(ok ? s2 : s) * NIN) : (u32x4){0u, 0u, 0u, 0u}; }
    float sum[8];
#pragma unroll
    for (int c = 0; c < 8; ++c) sum[c] = 0.f;
#pragma unroll
    for (int j = 0; j < W; ++j) { sum[0] += bf_lo(row[j].x); sum[1] += bf_hi(row[j].x); sum[2] += bf_lo(row[j].y); sum[3] += bf_hi(row[j].y); sum[4] += bf_lo(row[j].z); sum[5] += bf_hi(row[j].z); sum[6] += bf_lo(row[j].w); sum[7] += bf_hi(row[j].w); }
#pragma unroll
    for (int i = 0; i < 4; ++i) {
        int lo_ = s + i - W / 2, hi_ = lo_ + W; lo_ = lo_ < 0 ? 0 : lo_; hi_ = hi_ > SEQ ? SEQ : hi_;
        const float inv = 1.0f / (float)(hi_ - lo_);
        const u32x4 sv = row[i + W / 2];
        u32x4 o;
        o.x = cvt_pk_bf16(sum[0] * inv - bf_lo(sv.x), sum[1] * inv - bf_hi(sv.x)); o.y = cvt_pk_bf16(sum[2] * inv - bf_lo(sv.y), sum[3] * inv - bf_hi(sv.y));
        o.z = cvt_pk_bf16(sum[4] * inv - bf_lo(sv.z), sum[5] * inv - bf_hi(sv.z)); o.w = cvt_pk_bf16(sum[6] * inv - bf_lo(sv.w), sum[7] * inv - bf_hi(sv.w));
        *(u32x4*)(op + (size_t)i * DM) = o;
        if (i < 3) { const u32x4 a = row[i], b = row[i + W];
            sum[0] += bf_lo(b.x) - bf_lo(a.x); sum[1] += bf_hi(b.x) - bf_hi(a.x); sum[2] += bf_lo(b.y) - bf_lo(a.y); sum[3] += bf_hi(b.y) - bf_hi(a.y);
            sum[4] += bf_lo(b.z) - bf_lo(a.z); sum[5] += bf_hi(b.z) - bf_hi(a.z); sum[6] += bf_lo(b.w) - bf_lo(a.w); sum[7] += bf_hi(b.w) - bf_hi(a.w); }
    }
}

__device__ __forceinline__ const void* ldp(volatile LAS unsigned* ptab, int k) {
    const unsigned lo = __builtin_amdgcn_readfirstlane(ptab[2 * k]), hi = __builtin_amdgcn_readfirstlane(ptab[2 * k + 1]);
    return (const void*)(const __attribute__((address_space(1))) char*)(((unsigned long long)hi << 32) | lo);
}

__global__ void __launch_bounds__(NTHREADS, 2) fwd(Args args) {
    extern __shared__ __attribute__((aligned(16))) unsigned char lds_raw[];
    LAS unsigned char* lds = (LAS unsigned char*)lds_raw;
    const int tid_k = threadIdx.x;
    const int G = gridDim.x, bid = blockIdx.x, NGW = G * NWAVES;
    const int vb = (G % 8 == 0) ? (bid % 8) * (G / 8) + bid / 8 : bid;
    LAS int* l_tb = (LAS int*)(lds + L_TB); LAS int* l_cnt = (LAS int*)(lds + L_CNT); LAS int* l_yb = (LAS int*)(lds + L_YB);
    LAS int* l_hist = (LAS int*)(lds + L_HIST); LAS int* l_base = (LAS int*)(lds + L_BASE);

    for (int u = tid_k; u < (LDS_BYTES - STAGE_BYTES) / 4; u += NTHREADS) ((LAS unsigned*)(lds + STAGE_BYTES))[u] = 0u;
    __syncthreads();
    volatile LAS unsigned* ptab = (volatile LAS unsigned*)(lds + L_PTR);
    if (tid_k < 24) { const unsigned long long pv = (tid_k < 22) ? (unsigned long long)args.in[tid_k] : (tid_k == 22 ? (unsigned long long)args.out : (unsigned long long)args.ws); ptab[2 * tid_k] = (unsigned)pv; ptab[2 * tid_k + 1] = (unsigned)(pv >> 32); }
    __syncthreads();
    asm volatile("s_setreg_imm32_b32 hwreg(HW_REG_MODE, 23, 1), 1");
    if (!MK_PER_PHASE) (void)xcd_barrier_post((unsigned*)(args.ws + WS_CTL + CTL_BAR), (volatile LAS unsigned*)(lds + L_MISC) + 8);
#if MK_PER_PHASE
    const int lo = args.ph_lo, hi = args.ph_hi;
#define IN(k) (lo <= (k) && (k) < hi)
#define SEAM(k) do { if (IN(k) && IN((k) + 1)) { XcdBarrier b_; b_.bar = (unsigned*)((unsigned char*)ldp(ptab, 23) + (WS_CTL + CTL_BAR)); b_.x = xb_xcc_id(); b_.st = (volatile LAS unsigned*)(lds + L_MISC) + 8; xcd_barrier(b_); } } while (0)
#else
#define IN(k) true
#define SEAM(k) do { XcdBarrier b_; b_.bar = (unsigned*)((unsigned char*)ldp(ptab, 23) + (WS_CTL + CTL_BAR)); b_.x = xb_xcc_id(); b_.st = (volatile LAS unsigned*)(lds + L_MISC) + 8; xcd_barrier(b_); } while (0)
#endif

    if (IN(0)) {
        int tid = tid_k; asm volatile("" : "+v"(tid)); const int lane = tid & 63, wave = __builtin_amdgcn_readfirstlane(tid >> 6), gw = bid * NWAVES + wave; (void)lane; (void)gw;
        const float* const w_ada = (const float*)ldp(ptab, 4);
        const float* const cvec = (const float*)ldp(ptab, 1);
        const float* const c_ctx = (const float*)ldp(ptab, 3);
        const float* const b_ada = (const float*)ldp(ptab, 5);
        float* const modf = (float*)((unsigned char*)ldp(ptab, 23) + (WS_MODF));
        const float* const w_in = (const float*)ldp(ptab, 8);
        const float* const pool_w = (const float*)ldp(ptab, 10);
        const float* const pool_scale = (const float*)ldp(ptab, 11);
        bf16_t* const WinT = (bf16_t*)((unsigned char*)ldp(ptab, 23) + (WS_WIN));
        float* const cosT = (float*)((unsigned char*)ldp(ptab, 23) + (WS_ROPE));
        float* const sinT = (float*)((unsigned char*)ldp(ptab, 23) + (WS_ROPE + 128 * 16 * 4));
        const float* const w_out = (const float*)ldp(ptab, 12);
        bf16_t* const WoutT = (bf16_t*)((unsigned char*)ldp(ptab, 23) + (WS_WOUT));
        const float* const w_router = (const float*)ldp(ptab, 13);
        bf16_t* const WrT = (bf16_t*)((unsigned char*)ldp(ptab, 23) + (WS_WR));
        const float* const w_gate = (const float*)ldp(ptab, 15);
        const float* const w_up = (const float*)ldp(ptab, 16);
        const float* const ws_gate = (const float*)ldp(ptab, 18);
        const float* const ws_up = (const float*)ldp(ptab, 19);
        bf16_t* const WguT = (bf16_t*)((unsigned char*)ldp(ptab, 23) + (WS_WGU));
        const float* const w_down = (const float*)ldp(ptab, 17);
        const float* const ws_down = (const float*)ldp(ptab, 20);
        bf16_t* const WdT = (bf16_t*)((unsigned char*)ldp(ptab, 23) + (WS_WD));
        LAS float* scr = (LAS float*)(lds + wave * 16384);
        for (int cb = bid; cb < 6144 / 32; cb += G) {
            LAS float* part = (LAS float*)lds;
            LAS float* sil = (LAS float*)(lds + 16384);
            for (int i = tid; i < 5 * DM; i += NTHREADS) { const float v = (i < 4 * DM) ? cvec[i] : c_ctx[i - 4 * DM]; sil[i] = v / (1.0f + __expf(-v)); }
            const int col = cb * 32 + (lane & 31), ksub = wave * 2 + (lane >> 5);
            float wv[64];
#pragma unroll
            for (int kk = 0; kk < 64; ++kk) wv[kk] = w_ada[(size_t)(ksub * 64 + kk) * 6144 + col];
            __syncthreads();
            float a5[5] = {0.f, 0.f, 0.f, 0.f, 0.f};
#pragma unroll
            for (int kk = 0; kk < 64; ++kk) {
#pragma unroll
                for (int q = 0; q < 5; ++q) a5[q] += sil[q * DM + ksub * 64 + kk] * wv[kk]; }
#pragma unroll
            for (int q = 0; q < 5; ++q) part[(ksub * 5 + q) * 32 + (lane & 31)] = a5[q];
            __syncthreads();
            if (tid < 160) { const int q = tid >> 5, c = tid & 31; float sacc = 0.f;
#pragma unroll
                for (int ks = 0; ks < 16; ++ks) sacc += part[(ks * 5 + q) * 32 + c];
                modf[q * 6144 + cb * 32 + c] = sacc + b_ada[cb * 32 + c]; }
            VM_WAIT();
            __syncthreads();
            if (tid == 0) { __builtin_amdgcn_fence(__ATOMIC_RELEASE, "agent"); asm volatile("s_waitcnt vmcnt(0)" ::: "memory");
                __hip_atomic_fetch_add((unsigned*)((unsigned char*)ldp(ptab, 23) + (WS_CTL + CTL_ADA)), 1u, __ATOMIC_RELAXED, __HIP_MEMORY_SCOPE_AGENT); }
        }
        constexpr int I_FOLD = 4 * 8 * 16, I_ROPE = 32, I_WIN = 16 * 24, I_WOUT = 16 * 32, I_WR = 16 * 2, I_E = NEXP1 * 128;
        constexpr int NITEMS = I_FOLD + I_ROPE + I_WIN + I_WOUT + I_WR + 3 * I_E;
        const bool tail_fold = NGW >= I_FOLD;
        const int nrest = tail_fold ? NITEMS - I_FOLD : NITEMS, roff = tail_fold ? I_FOLD : 0;
        for (int n = tail_fold ? -1 : 0; ; ++n) {
            int r;
            if (n < 0) { r = NGW - 1 - gw; if (r >= I_FOLD) continue; }
            else { const int j = gw + n * NGW; if (j >= nrest) break; r = roff + j; }
            if (r < I_FOLD) {
                const int g = r >> 7, dblk = (r >> 4) & 7, kblk = r & 15, k = kblk * 64 + lane;
                float a16[16];
#pragma unroll
                for (int d = 0; d < 16; ++d) a16[d] = 0.f;
                const float* wrow = w_in + (size_t)k * NIN + 768 + g * 128; const float* pw = pool_w + (size_t)g * 128 * 128 + dblk * 16;
#pragma unroll
                for (int cq = 0; cq < 4; ++cq) { f32x4 wv4[8];
#pragma unroll
                    for (int i = 0; i < 8; ++i) wv4[i] = *(const f32x4*)(wrow + 32 * cq + 4 * i);
#pragma unroll
                    for (int i = 0; i < 8; ++i)
#pragma unroll
                        for (int j = 0; j < 4; ++j) { const int c = 32 * cq + 4 * i + j; const float a = wv4[i][j];
#pragma unroll
                            for (int d = 0; d < 16; ++d) a16[d] += a * pw[c * 128 + d]; } }
#pragma unroll
                for (int d = 0; d < 16; ++d) { const int np = g * 128 + dblk * 16 + d; const int drow = 768 + (np & ~31) + invperm32(np & 31);
                    WinT[(size_t)drow * DM + k] = (bf16_t)(cvt_pk_bf16(a16[d] * pool_scale[np], 0.f) & 0xffffu); }
                continue; } r -= I_FOLD;
            if (r < I_ROPE) { const int en = r * 64 + lane, pos = en >> 4, d = en & 15; const float inv = powf(10000.0f, -(float)d / 16.0f), ang = (float)pos * inv;
                cosT[en] = cosf(ang); sinT[en] = sinf(ang); continue; } r -= I_ROPE;
            if (r < I_WIN) { const int kb = r / 24, nbk = r % 24, n0 = nbk * 32; transpose_item(w_in, NIN, kb * 64, n0, WinT, DM, n0, n0 >= 640, scr, lane); continue; } r -= I_WIN;
            if (r < I_WOUT) { const int kb = r >> 5, n0 = (r & 31) * 32; transpose_item(w_out, DM, kb * 64, n0, WoutT, DM, n0, true, scr, lane); continue; } r -= I_WOUT;
            if (r < I_WR) { const int kb = r >> 1, n0 = (r & 1) * 32; transpose_item(w_router, NEXP, kb * 64, n0, WrT, DM, n0, false, scr, lane); continue; } r -= I_WR;
            if (r < 2 * I_E) {
                const int up = r >= I_E; if (up) r -= I_E;
                const int e = r >> 7, q = r & 127, kb = q >> 3, n0 = (q & 7) * 32;
                const float* src = (e < NEXP) ? (up ? w_up : w_gate) + (size_t)e * DM * DEXP : (up ? ws_up : ws_gate);
                transpose_item8(src, DEXP, kb * 64, n0, (unsigned char*)WguT + (size_t)e * 512 * DM, DM, 256 * (n0 >> 7) + 128 * up + (n0 & 127), 1, scr, lane, 32.0f); continue; } r -= 2 * I_E;
            { const int e = r >> 7, q = r & 127, kb = q >> 5, n0 = (q & 31) * 32;
              const float* src = (e < NEXP) ? w_down + (size_t)e * DEXP * DM : ws_down;
              transpose_item8(src, DM, kb * 64, n0, (unsigned char*)WdT + (size_t)e * DM * DEXP, DEXP, n0, 3, scr, lane, 16.0f); }
        }
    }
#if MK_PER_PHASE
    SEAM(0);
#else
    {
        if (tid_k == 0) { unsigned* const cnt_ada = (unsigned*)((unsigned char*)ldp(ptab, 23) + (WS_CTL + CTL_ADA)); unsigned sp = 0;
            while (__hip_atomic_load(cnt_ada, __ATOMIC_RELAXED, __HIP_MEMORY_SCOPE_AGENT) < 6144u / 32u) { __builtin_amdgcn_s_sleep(2); if (++sp > (1u << 22)) break; }
            __builtin_amdgcn_fence(__ATOMIC_ACQUIRE, "agent"); asm volatile("s_waitcnt vmcnt(0)" ::: "memory"); }
        __syncthreads();
    }
#endif

    if (IN(1)) {
        int tid = tid_k; asm volatile("" : "+v"(tid)); const int lane = tid & 63, wave = __builtin_amdgcn_readfirstlane(tid >> 6), gw = bid * NWAVES + wave; (void)lane; (void)gw;
        const float* const x_in = (const float*)ldp(ptab, 0);
        const float* const ctx = (const float*)ldp(ptab, 2);
        const float* const norm1_g = (const float*)ldp(ptab, 6);
        float* const modf = (float*)((unsigned char*)ldp(ptab, 23) + (WS_MODF));
        bf16_t* const hx = (bf16_t*)((unsigned char*)ldp(ptab, 23) + (WS_HX));
        for (int rb = gw; rb < NTOK / 16 + NCTX; rb += NGW) {
            const bool isx = rb < NTOK / 16; const int m0 = isx ? rb * 16 : NTOK + (rb - NTOK / 16), nrow = isx ? 16 : 1, q = isx ? m0 / SEQ : 4;
            f32x4 ga[4], sha[4];
#pragma unroll
            for (int j = 0; j < 4; ++j) { const int col = 4 * lane + 256 * j;
                ga[j] = *(const f32x4*)(norm1_g + col) * (*(const f32x4*)(modf + q * 6144 + DM + col) + 1.0f); sha[j] = *(const f32x4*)(modf + q * 6144 + col); }
#pragma unroll 4
            for (int r = 0; r < nrow; ++r) {
                const int m = m0 + r;
                const float* src = (m < NTOK) ? x_in + (size_t)m * DM : ctx + (size_t)(m - NTOK) * DM;
                const f32x4* xr = (const f32x4*)src + lane;
                f32x4 v[4]; float ss = 0.f;
#pragma unroll
                for (int j = 0; j < 4; ++j) { v[j] = xr[64 * j]; ss += (v[j].x * v[j].x + v[j].y * v[j].y) + (v[j].z * v[j].z + v[j].w * v[j].w); }
                const float rstd = rsqrtf(wave_sum(ss) * (1.f / DM) + EPS);
                unsigned long long* o8 = (unsigned long long*)(hx + (size_t)m * DM) + lane;
#pragma unroll
                for (int j = 0; j < 4; ++j) { const f32x4 h = (v[j] * rstd) * ga[j] + sha[j];
                    o8[64 * j] = (unsigned long long)cvt_pk_bf16(h.x, h.y) | ((unsigned long long)cvt_pk_bf16(h.z, h.w) << 32); }
            }
        }
    }
    SEAM(1);

    if (IN(2)) {
        int tid = tid_k; asm volatile("" : "+v"(tid)); const int lane = tid & 63, wave = __builtin_amdgcn_readfirstlane(tid >> 6), gw = bid * NWAVES + wave; (void)lane; (void)gw;
        bf16_t* const hx = (bf16_t*)((unsigned char*)ldp(ptab, 23) + (WS_HX));
        bf16_t* const WinT = (bf16_t*)((unsigned char*)ldp(ptab, 23) + (WS_WIN));
        bf16_t* const zb = (bf16_t*)((unsigned char*)ldp(ptab, 23) + (WS_Z));
        float* const cosT = (float*)((unsigned char*)ldp(ptab, 23) + (WS_ROPE));
        float* const sinT = (float*)((unsigned char*)ldp(ptab, 23) + (WS_ROPE + 128 * 16 * 4));
        pg8::SchedStatic S; S.nM = NTOK / 256; S.nN = NIN / 256; S.nwg = S.nM * S.nN; S.G = G; S.c = bid; S.extra = NCTX / 256; S.extra_pn = 2; S.A = (const char*)hx; S.Bt = (const char*)WinT; S.K = DM;
        EpiIn E{zb, cosT, sinT};
        pg8::gemm_phase<EpiIn, pg8::SchedStatic, false>(lds, S, E);
    }
    SEAM(2);

    if (IN(3)) {
        int tid = tid_k; asm volatile("" : "+v"(tid)); const int lane = tid & 63, wave = __builtin_amdgcn_readfirstlane(tid >> 6), gw = bid * NWAVES + wave; (void)lane; (void)gw;
        bf16_t* const zb = (bf16_t*)((unsigned char*)ldp(ptab, 23) + (WS_Z));
        const float* const attn_sink = (const float*)ldp(ptab, 9);
        bf16_t* const mix = (bf16_t*)((unsigned char*)ldp(ptab, 23) + (WS_MIX));
        constexpr int KS = 144;
        LAS unsigned char* kbuf = lds; LAS unsigned char* vbuf = lds + 2 * 64 * KS;
        const int quad = lane >> 4, l15 = lane & 15;
          for (int un = vb; un < NB * 64 * 2; un += G) {
            const int b = un >> 7, nblk = (un & 127) >> 1, kh = un & 1;
            const int hq = kh * 4 + (wave >> 1), qw0 = nblk * 128 + (wave & 1) * 64;
            bf16x8 qf[4][2];
#pragma unroll
            for (int qb = 0; qb < 4; ++qb)
#pragma unroll
                for (int ks = 0; ks < 2; ++ks) qf[qb][ks] = *(const bf16x8*)(zb + (size_t)(b * SEQ + qw0 + 16 * qb + l15) * NIN + hq * 64 + 32 * ks + 8 * quad);
            f32x4 O[4][4]; float mrun[4], lrun[4];
            const float sk = attn_sink[hq] * LOG2E;
#pragma unroll
            for (int qb = 0; qb < 4; ++qb) { mrun[qb] = sk; lrun[qb] = quad ? 0.0f : 1.0f;
#pragma unroll
                for (int db = 0; db < 4; ++db) O[db][qb] = (f32x4){0.f, 0.f, 0.f, 0.f}; }
            const int kstart = nblk * 128 - 128 < 0 ? 0 : nblk * 128 - 128, kend = nblk * 128 + 256 > SEQ ? SEQ : nblk * 128 + 256;
            const int ntile = 4 + (kend - kstart) / 64;
            const int lr = tid >> 3, lc = tid & 7;
            u32x4 kreg, vreg;
            { const size_t rowb = (size_t)(NTOK + b * CTXL + lr);
              kreg = *(const u32x4*)(zb + rowb * NIN + 512 + kh * 64 + 8 * lc); vreg = *(const u32x4*)(zb + rowb * NIN + 640 + kh * 64 + 8 * lc); }
            *(LAS u32x4*)(kbuf + lr * KS + lc * 16) = kreg; *(LAS u32x4*)(vbuf + lr * KS + lc * 16) = vreg;
            __syncthreads();
            for (int it = 0; it < ntile; ++it) {
                const int cb = it & 1;
                if (it + 1 < ntile) { const int i2 = it + 1;
                    const size_t rowb = (i2 < 4) ? (size_t)(NTOK + b * CTXL + i2 * 64 + lr) : (size_t)(b * SEQ + kstart + (i2 - 4) * 64 + lr);
                    kreg = *(const u32x4*)(zb + rowb * NIN + 512 + kh * 64 + 8 * lc); vreg = *(const u32x4*)(zb + rowb * NIN + 640 + kh * 64 + 8 * lc); }
                const int k0 = kstart + (it - 4) * 64;
                const bool active = (it < 4) || (k0 <= qw0 + 63 + 128 && k0 + 63 >= qw0 - 128);
                const bool needmask = (it >= 4) && !(k0 >= qw0 + 63 - 128 && k0 + 63 <= qw0 + 128);
                if (active) {
                    const LAS unsigned char* kt = kbuf + cb * 64 * KS; const LAS unsigned char* vt = vbuf + cb * 64 * KS;
                    f32x4 St[4][4];
                    { bf16x8 kf[4][2];
#pragma unroll
                      for (int kb = 0; kb < 4; ++kb)
#pragma unroll
                        for (int ks = 0; ks < 2; ++ks) kf[kb][ks] = *(const LAS bf16x8*)(kt + (16 * kb + l15) * KS + (32 * ks + 8 * quad) * 2);
#pragma unroll
                      for (int kb = 0; kb < 4; ++kb)
#pragma unroll
                        for (int qb = 0; qb < 4; ++qb) St[kb][qb] = __builtin_amdgcn_mfma_f32_16x16x32_bf16(kf[kb][0], qf[qb][0], (f32x4){0.f, 0.f, 0.f, 0.f}, 0, 0, 0);
#pragma unroll
                      for (int kb = 0; kb < 4; ++kb)
#pragma unroll
                        for (int qb = 0; qb < 4; ++qb) St[kb][qb] = __builtin_amdgcn_mfma_f32_16x16x32_bf16(kf[kb][1], qf[qb][1], St[kb][qb], 0, 0, 0);
                    }
                    bf16x8 vfr0[4], vfr1[4];
#define LOAD_VFR(dst, ks) do { _Pragma("unroll") for (int db = 0; db < 4; ++db) { \
                            const LAS unsigned char* va = vt + (32 * (ks) + 4 * quad + (l15 >> 2)) * KS + (16 * db + 4 * (l15 & 3)) * 2; \
                            const s16x4 v0 = __builtin_amdgcn_ds_read_tr16_b64_v4i16((LAS s16x4*)va); \
                            const s16x4 v1 = __builtin_amdgcn_ds_read_tr16_b64_v4i16((LAS s16x4*)(va + 16 * KS)); \
                            dst[db] = __builtin_shufflevector(v0, v1, 0, 1, 2, 3, 4, 5, 6, 7); } } while (0)
                    LOAD_VFR(vfr0, 0);
                    __builtin_amdgcn_sched_barrier(0);
                    if (needmask) {
#pragma unroll
                        for (int kb = 0; kb < 4; ++kb)
#pragma unroll
                            for (int qb = 0; qb < 4; ++qb)
#pragma unroll
                                for (int r = 0; r < 4; ++r) { const int dl = (k0 + 16 * kb + 4 * quad + r) - (qw0 + 16 * qb + l15);
                                    if (dl > 128 || dl < -128) St[kb][qb][r] = -__builtin_inff(); }
                    }
                    bf16x8 pf[4][2];
#pragma unroll
                    for (int qb = 0; qb < 4; ++qb) {
                        float mx = -__builtin_inff();
#pragma unroll
                        for (int kb = 0; kb < 4; ++kb) mx = fmaxf(mx, fmaxf(fmaxf(St[kb][qb][0], St[kb][qb][1]), fmaxf(St[kb][qb][2], St[kb][qb][3])));
                        mx = quad_allmax(mx);
                        const float mnew = fmaxf(mrun[qb], mx), alpha = __builtin_amdgcn_exp2f(mrun[qb] - mnew);
                        float rs = 0.f;
#pragma unroll
                        for (int kb = 0; kb < 4; ++kb)
#pragma unroll
                            for (int r = 0; r < 4; ++r) { const float p = __builtin_amdgcn_exp2f(St[kb][qb][r] - mnew); St[kb][qb][r] = p; rs += p; }
                        lrun[qb] = lrun[qb] * alpha + rs; mrun[qb] = mnew;
                        if (__any(alpha != 1.0f)) {
#pragma unroll
                            for (int db = 0; db < 4; ++db) O[db][qb] = O[db][qb] * alpha; }
#pragma unroll
                        for (int ks = 0; ks < 2; ++ks) { u32x4 w;
                            w.x = cvt_pk_bf16(St[2 * ks][qb][0], St[2 * ks][qb][1]); w.y = cvt_pk_bf16(St[2 * ks][qb][2], St[2 * ks][qb][3]);
                            w.z = cvt_pk_bf16(St[2 * ks + 1][qb][0], St[2 * ks + 1][qb][1]); w.w = cvt_pk_bf16(St[2 * ks + 1][qb][2], St[2 * ks + 1][qb][3]);
                            pf[qb][ks] = __builtin_bit_cast(bf16x8, w); }
                    }
                    LOAD_VFR(vfr1, 1);
#undef LOAD_VFR
                    __builtin_amdgcn_sched_barrier(0);
#pragma unroll
                    for (int db = 0; db < 4; ++db)
#pragma unroll
                        for (int qb = 0; qb < 4; ++qb) O[db][qb] = __builtin_amdgcn_mfma_f32_16x16x32_bf16(vfr0[db], pf[qb][0], O[db][qb], 0, 0, 0);
#pragma unroll
                    for (int db = 0; db < 4; ++db)
#pragma unroll
                        for (int qb = 0; qb < 4; ++qb) O[db][qb] = __builtin_amdgcn_mfma_f32_16x16x32_bf16(vfr1[db], pf[qb][1], O[db][qb], 0, 0, 0);
                }
                if (it + 1 < ntile) { const int nbuf = cb ^ 1;
                    *(LAS u32x4*)(kbuf + nbuf * 64 * KS + lr * KS + lc * 16) = kreg; *(LAS u32x4*)(vbuf + nbuf * 64 * KS + lr * KS + lc * 16) = vreg; }
                __syncthreads();
            }
#pragma unroll
            for (int qb = 0; qb < 4; ++qb) { const float inv = 1.0f / quad_allsum(lrun[qb]);
                bf16_t* orow = mix + (size_t)(b * SEQ + qw0 + 16 * qb + l15) * DM + hq * 64 + 4 * quad;
#pragma unroll
                for (int db = 0; db < 4; ++db) { const f32x4 o = O[db][qb] * inv; u32x2 w; w.x = cvt_pk_bf16(o[0], o[1]); w.y = cvt_pk_bf16(o[2], o[3]); *(u32x2*)(orow + 16 * db) = w; } }
        }
          for (int blk = bid; blk < NTOK / 32; blk += G) {
            const int t = blk * 32 + (tid & 7) * 4, ch = tid >> 3, c0 = 8 * ch, g = wave >> 1;
            const int s = t & (SEQ - 1);
            const bf16_t* zp = zb + (size_t)(t - s) * NIN + 768 + c0;
            bf16_t* op = mix + (size_t)t * DM + 512 + c0;
            if (g == 0) pool4<2>(zp, s, op); else if (g == 1) pool4<4>(zp, s, op); else if (g == 2) pool4<8>(zp, s, op); else pool4<16>(zp, s, op);
        }
    }
    SEAM(3);

    if (IN(4)) {
        int tid = tid_k; asm volatile("" : "+v"(tid)); const int lane = tid & 63, wave = __builtin_amdgcn_readfirstlane(tid >> 6), gw = bid * NWAVES + wave; (void)lane; (void)gw;
        bf16_t* const mix = (bf16_t*)((unsigned char*)ldp(ptab, 23) + (WS_MIX));
        bf16_t* const WoutT = (bf16_t*)((unsigned char*)ldp(ptab, 23) + (WS_WOUT));
        const float* const x_in = (const float*)ldp(ptab, 0);
        float* const modf = (float*)((unsigned char*)ldp(ptab, 23) + (WS_MODF));
        unsigned char* const outb = (unsigned char*)ldp(ptab, 22);
        pg8::SchedStatic S; S.nM = NTOK / 256; S.nN = DM / 256; S.nwg = S.nM * S.nN; S.G = G; S.c = bid; S.extra = 0; S.extra_pn = 0; S.A = (const char*)mix; S.Bt = (const char*)WoutT; S.K = DM;
        EpiOut E{x_in, modf, outb};
        pg8::gemm_phase<EpiOut, pg8::SchedStatic, false>(lds, S, E);
    }
    SEAM(4);

    if (IN(6)) {
        int tid = tid_k; asm volatile("" : "+v"(tid)); const int lane = tid & 63, wave = __builtin_amdgcn_readfirstlane(tid >> 6), gw = bid * NWAVES + wave; (void)lane; (void)gw;
        unsigned char* const hx8 = (unsigned char*)ldp(ptab, 23) + (WS_HX8);
        const float* const norm2_g = (const float*)ldp(ptab, 7);
        float* const modf = (float*)((unsigned char*)ldp(ptab, 23) + (WS_MODF));
        unsigned char* const outb = (unsigned char*)ldp(ptab, 22);
        bf16_t* const WrT = (bf16_t*)((unsigned char*)ldp(ptab, 23) + (WS_WR));
        const float* const router_bias = (const float*)ldp(ptab, 14);
        unsigned* const counts = (unsigned*)((unsigned char*)ldp(ptab, 23) + (WS_CTL + CTL_CNT));
        unsigned* const asg = (unsigned*)((unsigned char*)ldp(ptab, 23) + (WS_ASG));
        float* const gatev = (float*)((unsigned char*)ldp(ptab, 23) + (WS_GATE));
        int* const rtok_g = (int*)((unsigned char*)ldp(ptab, 23) + (WS_RTOK));
        const int quad = lane >> 4, l15 = lane & 15;
        for (int idx = tid; idx < NEXP * 128; idx += NTHREADS) { const int e = idx >> 7, c = idx & 127;
            *(LAS u32x4*)(lds + e * 2048 + ((c ^ (4 * (e >> 4) + (e & 3))) << 4)) = *(const u32x4*)(WrT + (size_t)e * DM + 8 * c); }
        __syncthreads();
        for (int bi = bid; bi < NTOK / 128; bi += G) {
            if (tid < 64) l_hist[tid] = 0;
            __syncthreads();
            const int t0 = bi * 128 + wave * 16, chunk = (bi * 128) / CH, t = t0 + l15;
            f32x4 g2a[4], sh2a[4];
            { const int q = t0 / SEQ;
#pragma unroll
              for (int hq = 0; hq < 4; ++hq) { const int col = 8 * lane + 512 * (hq >> 1) + 4 * (hq & 1);
                g2a[hq] = *(const f32x4*)(norm2_g + col) * (*(const f32x4*)(modf + q * 6144 + 4 * DM + col) + 1.0f); sh2a[hq] = *(const f32x4*)(modf + q * 6144 + 3 * DM + col); } }
#pragma unroll 4
            for (int r = 0; r < 16; ++r) {
                const int m = t0 + r; unsigned char* rowp = outb + (size_t)m * 4096;
                float v[16]; float ss = 0.f;
#pragma unroll
                for (int h = 0; h < 2; ++h) { const u32x4 w = *(const u32x4*)(rowp + (8 * lane + 512 * h) * 2);
                    v[8 * h + 0] = bf_lo(w.x); v[8 * h + 1] = bf_hi(w.x); v[8 * h + 2] = bf_lo(w.y); v[8 * h + 3] = bf_hi(w.y); v[8 * h + 4] = bf_lo(w.z); v[8 * h + 5] = bf_hi(w.z); v[8 * h + 6] = bf_lo(w.w); v[8 * h + 7] = bf_hi(w.w); }
#pragma unroll
                for (int j = 0; j < 16; ++j) ss += v[j] * v[j];
                const float rstd = rsqrtf(wave_sum(ss) * (1.f / DM) + EPS);
#pragma unroll
                for (int h = 0; h < 2; ++h) { const int col = 8 * lane + 512 * h; float o[8];
#pragma unroll
                    for (int hh = 0; hh < 2; ++hh) {
#pragma unroll
                        for (int j = 0; j < 4; ++j) o[4 * hh + j] = (v[8 * h + 4 * hh + j] * rstd) * g2a[2 * h + hh][j] + sh2a[2 * h + hh][j]; }
                    (void)col;
                    u32x4 w; w.x = cvt_pk_bf16(o[0], o[1]); w.y = cvt_pk_bf16(o[2], o[3]); w.z = cvt_pk_bf16(o[4], o[5]); w.w = cvt_pk_bf16(o[6], o[7]);
                    *(u32x4*)(rowp + 2048 + col * 2) = w;
                    u32x2 w8; int pk = 0;
                    pk = __builtin_amdgcn_cvt_pk_fp8_f32(o[0], o[1], pk, false); pk = __builtin_amdgcn_cvt_pk_fp8_f32(o[2], o[3], pk, true); w8.x = (unsigned)pk;
                    pk = __builtin_amdgcn_cvt_pk_fp8_f32(o[4], o[5], pk, false); pk = __builtin_amdgcn_cvt_pk_fp8_f32(o[6], o[7], pk, true); w8.y = (unsigned)pk;
                    *(u32x2*)(hx8 + (size_t)m * DM + col) = w8; }
            }
            VM_WAIT();
            const unsigned char* arow = outb + (size_t)t * 4096 + 2048 + 16 * quad;
            bf16x8 bfr[32];
#pragma unroll
            for (int s = 0; s < 32; ++s) bfr[s] = *(const bf16x8*)(arow + 64 * s);
            f32x4 acc[4];
#pragma unroll
            for (int nb = 0; nb < 4; ++nb) acc[nb] = (f32x4){0.f, 0.f, 0.f, 0.f};
            const LAS unsigned char* wl = lds + (16 * (l15 >> 2) + (l15 & 3)) * 2048;
#pragma unroll
            for (int s = 0; s < 32; ++s)
#pragma unroll
                for (int nb = 0; nb < 4; ++nb) { const bf16x8 af = *(const LAS bf16x8*)(wl + nb * 4 * 2048 + (((4 * s + quad) ^ l15) << 4)); acc[nb] = __builtin_amdgcn_mfma_f32_16x16x32_bf16(af, bfr[s], acc[nb], 0, 0, 0); }
            float sc[16], cand[16];
#pragma unroll
            for (int nb = 0; nb < 4; ++nb) { const f32x4 bs = *(const f32x4*)(router_bias + 16 * quad + 4 * nb);
#pragma unroll
                for (int r = 0; r < 4; ++r) { const float sg = 1.0f / (1.0f + __expf(-acc[nb][r])); sc[4 * nb + r] = sg; cand[4 * nb + r] = sg + bs[r]; } }
            float gA, gB;
            { float m1 = -__builtin_inff(), m2 = -__builtin_inff();
#pragma unroll
              for (int i = 0; i < 8; ++i) { const float v = cand[i]; if (v > m1) { m2 = m1; m1 = v; } else if (v > m2) m2 = v; }
              gA = m1 + m2; m1 = -__builtin_inff(); m2 = -__builtin_inff();
#pragma unroll
              for (int i = 8; i < 16; ++i) { const float v = cand[i]; if (v > m1) { m2 = m1; m1 = v; } else if (v > m2) m2 = v; }
              gB = m1 + m2; }
            float gs[8];
#pragma unroll
            for (int q = 0; q < 4; ++q) { gs[2 * q] = __shfl(gA, l15 + 16 * q); gs[2 * q + 1] = __shfl(gB, l15 + 16 * q); }
            unsigned gmask = 0u;
#pragma unroll
            for (int it = 0; it < 4; ++it) { float best = -__builtin_inff(); int bi_ = 0;
#pragma unroll
                for (int g = 0; g < 8; ++g) if (!((gmask >> g) & 1u) && gs[g] > best) { best = gs[g]; bi_ = g; }
                gmask |= 1u << bi_; }
            const bool selA = (gmask >> (2 * quad)) & 1u, selB = (gmask >> (2 * quad + 1)) & 1u;
#pragma unroll
            for (int i = 0; i < 16; ++i) cand[i] = ((i < 8) ? selA : selB) ? cand[i] : -__builtin_inff();
            int esel[8]; float ssel[8]; float ssum = 0.f;
#pragma unroll
            for (int k = 0; k < 8; ++k) {
                float bvv = -__builtin_inff(), bs = 0.f; int bi_ = 0;
#pragma unroll
                for (int i = 0; i < 16; ++i) if (cand[i] > bvv) { bvv = cand[i]; bi_ = i; bs = sc[i]; }
                int be = 16 * quad + bi_;
#pragma unroll
                for (int off = 16; off <= 32; off <<= 1) { const float ov = __shfl_xor(bvv, off), os = __shfl_xor(bs, off); const int oe = __shfl_xor(be, off);
                    if (ov > bvv || (ov == bvv && oe < be)) { bvv = ov; be = oe; bs = os; } }
                esel[k] = be; ssel[k] = bs; ssum += bs;
#pragma unroll
                for (int i = 0; i < 16; ++i) if (be == 16 * quad + i) cand[i] = -__builtin_inff();
            }
            const float rn = 2.5f / ssum;
            int e0 = esel[0], e1 = esel[1]; float g0 = ssel[0], g1 = ssel[1];
#pragma unroll
            for (int q = 1; q < 4; ++q) if (quad == q) { e0 = esel[2 * q]; e1 = esel[2 * q + 1]; g0 = ssel[2 * q]; g1 = ssel[2 * q + 1]; }
            const int r0 = __hip_atomic_fetch_add(l_hist + e0, 1, __ATOMIC_RELAXED, __HIP_MEMORY_SCOPE_WORKGROUP);
            const int r1 = __hip_atomic_fetch_add(l_hist + e1, 1, __ATOMIC_RELAXED, __HIP_MEMORY_SCOPE_WORKGROUP);
            __syncthreads();
            if (tid < 64) { const int hcount = l_hist[tid]; l_base[tid] = hcount ? (int)atomicAdd(counts + chunk * 64 + tid, (unsigned)hcount) : 0; }
            __syncthreads();
            const int s0 = l_base[e0] + r0, s1 = l_base[e1] + r1;
            u32x2 pa; pa.x = ((unsigned)e0 << 16) | (unsigned)s0; pa.y = ((unsigned)e1 << 16) | (unsigned)s1;
            *(u32x2*)(asg + (size_t)t * 8 + 2 * quad) = pa;
            f32x2 pg; pg.x = g0 * rn; pg.y = g1 * rn; *(f32x2*)(gatev + (size_t)t * 8 + 2 * quad) = pg;
            rtok_g[((size_t)chunk * 64 + e0) * CH + s0] = t; rtok_g[((size_t)chunk * 64 + e1) * CH + s1] = t;
            __syncthreads();
        }
    }
    SEAM(6);

    {
        if (IN(7) || IN(8)) {
            __syncthreads();
            unsigned* const counts = (unsigned*)((unsigned char*)ldp(ptab, 23) + (WS_CTL + CTL_CNT));
            if (tid_k == 0) { int tsum = 0, ysum = 0;
#pragma nounroll
                for (int e = 0; e < NEXP1; ++e) { const int n = (e < NEXP) ? (int)counts[e] : CH; l_tb[e] = tsum; l_cnt[e] = n; l_yb[e] = ysum; tsum += (n + 255) >> 8; ysum += n; }
                l_tb[NEXP1] = tsum; }
            __syncthreads();
        }
        if (IN(7)) {
        int tid = tid_k; asm volatile("" : "+v"(tid)); const int lane = tid & 63, wave = __builtin_amdgcn_readfirstlane(tid >> 6), gw = bid * NWAVES + wave; (void)lane; (void)gw;
            unsigned char* const outb = (unsigned char*)ldp(ptab, 22);
            bf16_t* const WguT = (bf16_t*)((unsigned char*)ldp(ptab, 23) + (WS_WGU));
            bf16_t* const WdT = (bf16_t*)((unsigned char*)ldp(ptab, 23) + (WS_WD));
            int* const rtok_g = (int*)((unsigned char*)ldp(ptab, 23) + (WS_RTOK));
            unsigned char* const Hblk = (unsigned char*)ldp(ptab, 23) + (WS_H) + (size_t)bid * 256 * 256;
            unsigned char* const hx8 = (unsigned char*)ldp(ptab, 23) + (WS_HX8);
            unsigned char* const Yb = (unsigned char*)ldp(ptab, 23) + (WS_Y);
            const int ntiles = l_tb[NEXP1];
            for (int T = vb; T < ntiles; T += G) {
                int lo_ = 0, hi_ = NEXP1;
                while (hi_ - lo_ > 1) { const int mid = (lo_ + hi_) >> 1; if (l_tb[mid] <= T) lo_ = mid; else hi_ = mid; }
                const int e = __builtin_amdgcn_readfirstlane(lo_), j = __builtin_amdgcn_readfirstlane(T - l_tb[lo_]);
                { pg8::SchedTile S; S.cnt = l_cnt; S.e = e; S.j = j; S.nN = 2; S.A = (const char*)hx8; S.Bt = (const char*)WguT; S.bstride = (size_t)512 * DM; S.K = DM / 2; S.rtok = rtok_g; S.tok0 = 0; S.arow = DM; S.aofs = 0;
                  EpiGU E{Hblk, PROBE_F(32)};
                  pg8::gemm_phase<EpiGU, pg8::SchedTile, true, true>(lds, S, E); }
                moe_down_tile(lds, Hblk, (const unsigned char*)WdT + (size_t)e * DM * DEXP, Yb, (unsigned char*)ldp(ptab, 23) + (WS_CTL + 524288) + (size_t)bid * 1024, l_yb[e], l_cnt[e], j);
            }
        }
        SEAM(7);
        if (IN(8)) {
        int tid = tid_k; asm volatile("" : "+v"(tid)); const int lane = tid & 63, wave = __builtin_amdgcn_readfirstlane(tid >> 6), gw = bid * NWAVES + wave; (void)lane; (void)gw;
            unsigned char* const outb = (unsigned char*)ldp(ptab, 22);
            unsigned* const asg = (unsigned*)((unsigned char*)ldp(ptab, 23) + (WS_ASG));
            float* const gatev = (float*)((unsigned char*)ldp(ptab, 23) + (WS_GATE));
            unsigned char* const Yb = (unsigned char*)ldp(ptab, 23) + (WS_Y);
            float* const modf = (float*)((unsigned char*)ldp(ptab, 23) + (WS_MODF));
            const float* const final_g = (const float*)ldp(ptab, 21);
            float* const out_f = (float*)ldp(ptab, 22);
            const int ck = 0;
            u32x4 pkA, pkB; f32x4 gtA, gtB;
            { const int m0 = ck * CH + gw; if (m0 < (ck + 1) * CH) { pkA = *(const u32x4*)(asg + (size_t)m0 * 8); pkB = *(const u32x4*)(asg + (size_t)m0 * 8 + 4); gtA = *(const f32x4*)(gatev + (size_t)m0 * 8); gtB = *(const f32x4*)(gatev + (size_t)m0 * 8 + 4); } }
            for (int m = ck * CH + gw; m < (ck + 1) * CH; m += NGW) {
                const int q = m / SEQ; unsigned char* rowp = outb + (size_t)m * 4096;
                const unsigned pk[8] = {pkA.x, pkA.y, pkA.z, pkA.w, pkB.x, pkB.y, pkB.z, pkB.w};
                const float gt[8] = {gtA.x, gtA.y, gtA.z, gtA.w, gtB.x, gtB.y, gtB.z, gtB.w};
                u32x4 yw[9];
#pragma unroll
                for (int k = 0; k < 9; ++k) { const int yrow = (k < 8) ? l_yb[pk[k] >> 16] + (int)(pk[k] & 0xffffu) : l_yb[NEXP] + (m - ck * CH);
                    yw[k] = *(const u32x4*)(Yb + (size_t)yrow * DM + 16 * lane); }
                const u32x4 xw0 = *(const u32x4*)(rowp + (16 * lane) * 2), xw1 = *(const u32x4*)(rowp + (16 * lane + 8) * 2);
                { const int mn = m + NGW; if (mn < (ck + 1) * CH) { pkA = *(const u32x4*)(asg + (size_t)mn * 8); pkB = *(const u32x4*)(asg + (size_t)mn * 8 + 4); gtA = *(const f32x4*)(gatev + (size_t)mn * 8); gtB = *(const f32x4*)(gatev + (size_t)mn * 8 + 4); } }
                float a[16];
#pragma unroll
                for (int j = 0; j < 16; ++j) a[j] = 0.f;
#pragma unroll
                for (int k = 0; k < 9; ++k) { const float gw_ = (k < 8 ? gt[k] : 1.0f) * 0.0625f; const u32x4 w = yw[k];
#pragma unroll
                    for (int d = 0; d < 4; ++d) { const f32x2 p0 = __builtin_amdgcn_cvt_pk_f32_fp8((int)w[d], false), p1 = __builtin_amdgcn_cvt_pk_f32_fp8((int)w[d], true);
                        a[4 * d + 0] += gw_ * p0.x; a[4 * d + 1] += gw_ * p0.y; a[4 * d + 2] += gw_ * p1.x; a[4 * d + 3] += gw_ * p1.y; } }
                float ss = 0.f;
                const int col = 16 * lane;
#pragma unroll
                for (int h = 0; h < 2; ++h) { const u32x4 w = h ? xw1 : xw0;
                    const float x1[8] = {bf_lo(w.x), bf_hi(w.x), bf_lo(w.y), bf_hi(w.y), bf_lo(w.z), bf_hi(w.z), bf_lo(w.w), bf_hi(w.w)};
#pragma unroll
                    for (int hh = 0; hh < 2; ++hh) { const f32x4 g2 = *(const f32x4*)(modf + q * 6144 + 5 * DM + col + 8 * h + 4 * hh);
#pragma unroll
                        for (int j = 0; j < 4; ++j) { const float v = x1[4 * hh + j] + g2[j] * a[8 * h + 4 * hh + j]; a[8 * h + 4 * hh + j] = v; ss += v * v; } } }
                const float rstd = rsqrtf(wave_sum(ss) * (1.f / DM) + EPS);
#pragma unroll
                for (int d = 0; d < 4; ++d) { const f32x4 fg = *(const f32x4*)(final_g + col + 4 * d); f32x4 o;
#pragma unroll
                    for (int j = 0; j < 4; ++j) o[j] = a[4 * d + j] * rstd * fg[j];
                    *(f32x4*)(out_f + (size_t)m * DM + col + 4 * d) = o; }
            }
        }
    }
#undef IN
#undef SEAM
}

extern "C" void kernel_launch(void* const* d_in, const int* in_sizes, int n_in, void* d_out, int out_size, void* d_ws, size_t ws_size, hipStream_t stream) {
    static int grid = 0;
    if (grid == 0) {
        if (n_in != 22 || in_sizes[0] != NTOK * DM || out_size != NTOK * DM || ws_size < WS_END) {
            fprintf(stderr, "kernel_launch: unexpected shapes (n_in %d, in0 %d, out %d, ws %zu, need %zu); nothing launched\n", n_in, n_in > 0 ? in_sizes[0] : -1, out_size, ws_size, (size_t)WS_END); grid = -1; return; }
        int dev = 0, cus = 0, per_cu = 0;
        if (hipGetDevice(&dev) != hipSuccess || hipDeviceGetAttribute(&cus, hipDeviceAttributeMultiprocessorCount, dev) != hipSuccess) { grid = -1; return; }
        if (hipFuncSetAttribute((const void*)fwd, hipFuncAttributeMaxDynamicSharedMemorySize, LDS_BYTES) != hipSuccess) { fprintf(stderr, "kernel_launch: hipFuncSetAttribute failed\n"); grid = -1; return; }
        if (hipOccupancyMaxActiveBlocksPerMultiprocessor(&per_cu, (const void*)fwd, NTHREADS, LDS_BYTES) != hipSuccess || per_cu < 1) { fprintf(stderr, "kernel_launch: occupancy query says %d blocks per CU\n", per_cu); (void)hipGetLastError(); grid = -1; return; }
        grid = cus < 256 ? cus : 256;
    }
    if (grid < 0) return;
    if (hipMemsetAsync((char*)d_ws + WS_CTL, 0, CTL_BYTES, stream) != hipSuccess) return;
    Args a{};
    for (int i = 0; i < 22; ++i) a.in[i] = (const float*)d_in[i];
    a.out = (float*)d_out; a.ws = (unsigned char*)d_ws;
#if MK_PER_PHASE
    for (int ph = 0; ph < NPHASE; ++ph) { a.ph_lo = ph; a.ph_hi = ph + 1; hipLaunchKernelGGL(fwd, dim3(grid), dim3(NTHREADS), LDS_BYTES, stream, a); }
#else
    a.ph_lo = 0; a.ph_hi = NPHASE; hipLaunchKernelGGL(fwd, dim3(grid), dim3(NTHREADS), LDS_BYTES, stream, a);
#endif
}
```

```cpp
#include <hip/hip_runtime.h>
#include <cstdio>
#include <cstdint>

#define PROBE_F(b) 0
#ifndef MK_PER_PHASE
#define MK_PER_PHASE 0
#endif

#define LAS __attribute__((address_space(3)))
typedef unsigned short bf16_t;
typedef short bf16x8 __attribute__((ext_vector_type(8)));
typedef short s16x4 __attribute__((ext_vector_type(4)));
typedef float f32x4 __attribute__((ext_vector_type(4)));
typedef unsigned u32x4 __attribute__((ext_vector_type(4)));
typedef unsigned u32x2 __attribute__((ext_vector_type(2)));
typedef float f32x2 __attribute__((ext_vector_type(2)));
typedef int i32x4 __attribute__((ext_vector_type(4)));
typedef int i32x8 __attribute__((ext_vector_type(8)));

constexpr int NB = 4, SEQ = 8192, DM = 1024, NTOK = NB * SEQ, CTXL = 256, NCTX = NB * CTXL, MROWS = NTOK + NCTX;
constexpr int NIN = 1280, NEXP = 64, NEXP1 = 65, DEXP = 256;
constexpr int NCH = 1, CH = NTOK / NCH;
constexpr float EPS = 1e-6f, LOG2E = 1.4426950408889634f;
constexpr int NWAVES = 8, NTHREADS = 512;
constexpr int NPHASE = 9;

constexpr size_t MiB = 1u << 20;
constexpr size_t WS_CTL = 0, CTL_BYTES = 1 * MiB;
constexpr size_t CTL_ADA = 8192;
constexpr size_t CTL_BAR = 16384;
constexpr size_t CTL_MOD = 65536;
constexpr size_t CTL_CNT = 262144;
constexpr size_t WS_ROPE = 1 * MiB;
constexpr size_t WS_MODF = 1 * MiB + 65536;
constexpr size_t WS_WIN = 2 * MiB;
constexpr size_t WS_WOUT = 5 * MiB;
constexpr size_t WS_WR = 7 * MiB;
constexpr size_t WS_WGU = 8 * MiB;
constexpr size_t WS_WD = 41 * MiB;
constexpr size_t WS_ASG = 58 * MiB;
constexpr size_t WS_GATE = 59 * MiB;
constexpr size_t WS_RTOK = 60 * MiB;
constexpr size_t WS_BIG = 68 * MiB;
constexpr size_t WS_HX = WS_BIG;
constexpr size_t WS_Z = WS_BIG + 66 * MiB;
constexpr size_t WS_MIX = WS_BIG + 149 * MiB;
constexpr size_t WS_H = WS_BIG;
constexpr size_t WS_Y = WS_BIG + 80 * MiB;
constexpr size_t WS_HX8 = WS_Y + (size_t)NTOK * 9 * 1024;
constexpr size_t WS_END = WS_HX8 + (size_t)NTOK * 1024;
static_assert(WS_Z + (size_t)MROWS * NIN * 2 <= WS_MIX && WS_MIX + (size_t)NTOK * DM * 2 <= 512 * MiB, "ws map");
static_assert(WS_END <= 512 * MiB, "ws map");

constexpr int STAGE_BYTES = 131072;
constexpr int L_MISC = STAGE_BYTES;
constexpr int L_TB = L_MISC + 128;
constexpr int L_CNT = L_TB + 66 * 4 + 8;
constexpr int L_YB = L_CNT + 65 * 4 + 12;
constexpr int L_HIST = L_YB + 65 * 4 + 12;
constexpr int L_BASE = L_HIST + 256;
constexpr int L_PTR = L_BASE + 256;
constexpr int LDS_BYTES = STAGE_BYTES + 4096;
static_assert(L_PTR + 256 <= LDS_BYTES, "lds map");

__device__ __forceinline__ unsigned cvt_pk_bf16(float lo, float hi) { unsigned r; asm volatile("v_cvt_pk_bf16_f32 %0, %1, %2" : "=v"(r) : "v"(lo), "v"(hi)); return r; }
__device__ __forceinline__ float bf_lo(unsigned w) { return __uint_as_float(w << 16); }
__device__ __forceinline__ float bf_hi(unsigned w) { return __uint_as_float(w & 0xffff0000u); }
__device__ __forceinline__ float wave_sum(float v) {
#pragma unroll
    for (int o = 1; o < 64; o <<= 1) v += __shfl_xor(v, o);
    return v;
}
__device__ __forceinline__ int invperm32(int p) { return 16 * ((p >> 2) & 1) + 4 * (p >> 3) + (p & 3); }
__device__ __forceinline__ float quad_allmax(float x) {
    const auto r = __builtin_amdgcn_permlane16_swap(__float_as_uint(x), __float_as_uint(x), false, false);
    x = fmaxf(__uint_as_float(r[0]), __uint_as_float(r[1]));
    const auto q = __builtin_amdgcn_permlane32_swap(__float_as_uint(x), __float_as_uint(x), false, false);
    return fmaxf(__uint_as_float(q[0]), __uint_as_float(q[1]));
}
__device__ __forceinline__ float quad_allsum(float x) {
    const auto r = __builtin_amdgcn_permlane16_swap(__float_as_uint(x), __float_as_uint(x), false, false);
    x = __uint_as_float(r[0]) + __uint_as_float(r[1]);
    const auto q = __builtin_amdgcn_permlane32_swap(__float_as_uint(x), __float_as_uint(x), false, false);
    return __uint_as_float(q[0]) + __uint_as_float(q[1]);
}
#define LDS_WAIT() asm volatile("s_waitcnt lgkmcnt(0)" ::: "memory")
#define VM_WAIT() asm volatile("s_waitcnt vmcnt(0)" ::: "memory")

#define XB_TMO      128
#define XB_XCNT(j)  (256  + 64 * (j))
#define XB_XSUB(j)  (1280 + 64 * (j))
#define XB_XGEN(j)  (2304 + 64 * (j))
#define XB_TOP      3328
#define XB_TOPGEN   3392
#define XCD_BAR_WORDS 3456
#define XB_SPIN_CAP (1u << 18)
__device__ __forceinline__ unsigned xb_ld(unsigned* p)              { return __hip_atomic_load(p, __ATOMIC_RELAXED, __HIP_MEMORY_SCOPE_AGENT); }
__device__ __forceinline__ unsigned xb_add(unsigned* p, unsigned v) { return __hip_atomic_fetch_add(p, v, __ATOMIC_RELAXED, __HIP_MEMORY_SCOPE_AGENT); }
__device__ __forceinline__ unsigned xb_xcc_id() { return (unsigned)__builtin_amdgcn_s_getreg((3 << 11) | 20) & 0xFu; }
#define XB_SPIN(cond, bar) do { unsigned _sp = 0; while (cond) { __builtin_amdgcn_s_sleep(1); \
    if ((++_sp & 255u) == 0u) { if (xb_ld(&(bar)[XB_TMO])) break; if (_sp > XB_SPIN_CAP) { atomicAdd(&(bar)[XB_TMO], 1u); break; } } } } while (0)
struct XcdBarrier { unsigned* bar; unsigned x; volatile LAS unsigned* st; };
__device__ __forceinline__ XcdBarrier xcd_barrier_post(unsigned* bar, volatile LAS unsigned* st) {
    XcdBarrier b; b.bar = bar; b.x = xb_xcc_id(); b.st = st;
    if (threadIdx.x == 0) (void)xb_add(&bar[XB_XCNT(b.x)], 1u);
    return b;
}
__device__ __forceinline__ void xcd_barrier_complete(unsigned* bar, unsigned x, unsigned& nloc, unsigned& nx) {
    const unsigned G = gridDim.x * gridDim.y * gridDim.z;
    unsigned sum, cnt, mine, sp = 0u;
    for (;;) {
        sum = 0u; cnt = 0u; mine = 0u;
#pragma unroll
        for (unsigned j = 0; j < 16; ++j) { const unsigned c = xb_ld(&bar[XB_XCNT(j)]); sum += c; cnt += (c > 0u) ? 1u : 0u; mine = (j == x) ? c : mine; }
        if (sum == G) break;
        __builtin_amdgcn_s_sleep(1);
        if ((++sp & 255u) == 0u) { if (xb_ld(&bar[XB_TMO])) break; if (sp > XB_SPIN_CAP) { atomicAdd(&bar[XB_TMO], 1u); break; } }
    }
    nloc = mine > 0u ? mine : 1u; nx = cnt > 0u ? cnt : 1u;
}
__device__ __forceinline__ void xcd_barrier(const XcdBarrier& b) {
    asm volatile("s_waitcnt vmcnt(0)" ::: "memory");
    __syncthreads();
    if (threadIdx.x == 0) {
        unsigned* bar = b.bar;
        __builtin_amdgcn_s_waitcnt(0);
        unsigned nloc = b.st[0], nx = b.st[1];
        if (nloc == 0u) { xcd_barrier_complete(bar, b.x, nloc, nx); b.st[0] = nloc; b.st[1] = nx; }
        const unsigned old = xb_add(&bar[XB_XSUB(b.x)], 1u);
        const unsigned gen = old / nloc;
        if (old + 1u == (gen + 1u) * nloc) {
            __builtin_amdgcn_fence(__ATOMIC_RELEASE, "agent");
            asm volatile("s_waitcnt vmcnt(0)" ::: "memory");
            const unsigned og = xb_add(&bar[XB_TOP], 1u);
            const unsigned tg = og / nx;
            if (og + 1u == (tg + 1u) * nx) xb_add(&bar[XB_TOPGEN], 1u);
            else XB_SPIN(xb_ld(&bar[XB_TOPGEN]) == tg, bar);
            __builtin_amdgcn_fence(__ATOMIC_ACQUIRE, "agent");
            xb_add(&bar[XB_XGEN(b.x)], 1u);
            asm volatile("s_waitcnt vmcnt(0)" ::: "memory");
        } else {
            XB_SPIN(xb_ld(&bar[XB_XGEN(b.x)]) == gen, bar);
            __builtin_amdgcn_fence(__ATOMIC_ACQUIRE, "agent");
            asm volatile("s_waitcnt vmcnt(0)" ::: "memory");
        }
    }
    __syncthreads();
}

namespace pg8 {
constexpr int BM = 256, BK = 64, HALF = 128, HTB = HALF * BK * 2, NXCD = 8, WGM = 8;
__device__ __forceinline__ int lds_byte(int r, int c) { const int st = (r >> 4) * 2 + (c >> 5), rr = r & 15, cc = c & 31, ob = rr * 64 + cc * 2; return st * 1024 + (ob ^ (((ob >> 9) & 1) << 5)); }
__device__ __forceinline__ void stage_rc(int b, int& R, int& C) { const int st = b / 1024, sb = b % 1024, swz = sb ^ (((sb >> 9) & 1) << 5); R = (st >> 1) * 16 + swz / 64; C = (st & 1) * 32 + (swz % 64) / 2; }
struct Unit { int pm, pn, e, j; };

struct SchedStatic {
    int nM, nN, nwg, G, c, extra, extra_pn; const char* A; const char* Bt; int K;
    __device__ __forceinline__ bool next(int i, Unit& u) const {
        const int L = i * G + c; u.e = 0; u.j = 0;
        if (L >= nwg) { if (L >= nwg + extra) return false; u.pm = nM + (L - nwg); u.pn = extra_pn; return true; }
        int wgid = L; { const int q = nwg / NXCD, r = nwg % NXCD, xcd = wgid % NXCD, off = wgid / NXCD; wgid = (xcd < r ? xcd * (q + 1) : r * (q + 1) + (xcd - r) * q) + off; }
        const int nig = WGM * nN, gid = wgid / nig, fm = gid * WGM, gsz = (nM - fm) < WGM ? (nM - fm) : WGM;
        u.pm = fm + ((wgid % nig) % gsz); u.pn = (wgid % nig) / gsz; return true;
    }
    __device__ __forceinline__ const char* a_ptr(const Unit& u) const { return A + (size_t)u.pm * (size_t)(BM * 2) * K; }
    __device__ __forceinline__ const char* b_ptr(const Unit& u) const { return Bt + (size_t)u.pn * (size_t)(BM * 2) * K; }
    __device__ __forceinline__ unsigned a_off(const Unit&, int) const { return 0u; }
};
struct SchedTile {
    const LAS int* cnt; int e, j, nN; const char* A; const char* Bt; size_t bstride; int K;
    const int* rtok; int tok0;
    unsigned arow, aofs;
    __device__ __forceinline__ bool next(int i, Unit& u) const { if (i >= 2 * nN) return false; const int pn = i >= nN ? 1 : 0, k = i - pn * nN; u.e = e; u.j = j + k; u.pm = k; u.pn = pn; return true; }
    __device__ __forceinline__ const char* a_ptr(const Unit&) const { return A; }
    __device__ __forceinline__ const char* b_ptr(const Unit& u) const { return Bt + (size_t)u.e * bstride + (size_t)u.pn * (size_t)(BM * 2) * K; }
    __device__ __forceinline__ unsigned a_off(const Unit& u, int r) const {
        int slot = u.j * BM + r; const int n = cnt[u.e]; slot = slot < n ? slot : n - 1;
        const int tok = (u.e < NEXP) ? rtok[(size_t)u.e * CH + slot] : tok0 + slot;
        return (unsigned)tok * arow + aofs;
    }
};

template <class Epi, class Sched, bool GATHER, bool FP8 = false>
__device__ __forceinline__ void gemm_phase(LAS unsigned char* lds, const Sched& S, const Epi& E) {
    int tid = threadIdx.x; asm volatile("" : "+v"(tid));
    const int wid = __builtin_amdgcn_readfirstlane(tid >> 6), lane = tid & 63, wr = wid >> 2, wc = wid & 3, fr = lane & 15, fq = lane >> 4;
    const int K = S.K, nt = K / BK;
    unsigned voffA[2], voffB[2]; int RA[2], CA[2];
#pragma unroll
    for (int i = 0; i < 2; ++i) { int R, C; stage_rc(tid * 16 + i * 8192, R, C); RA[i] = R; CA[i] = C; voffA[i] = (unsigned)(R * K + C) * 2u; voffB[i] = (unsigned)(R * K + C) * 2u; }
    const size_t kstep = (size_t)(BK * 2);
    const size_t hstep = (size_t)HALF * K * 2;
    const unsigned ldsw = (unsigned)wid * 1024u;
    const int aoff = lds_byte(wr * 64 + fr, fq * 8), boff = lds_byte(wc * 32 + fr, fq * 8);
    unsigned gv[2][2];
#define PG8_SA(b, h) (((b) * 2 + (h)) * HTB)
#define PG8_SB(b, h) ((4 + (b) * 2 + (h)) * HTB)
#define PG8_STAGE(bufoff, gbase, voff) do { _Pragma("unroll") for (int _i = 0; _i < 2; ++_i) \
        __builtin_amdgcn_global_load_lds((const unsigned*)((const char*)(gbase) + (voff)[_i]), (LAS unsigned*)(lds + (bufoff) + ldsw + _i * 8192), 16, 0, 0); } while (0)
#define PG8_STAGE_A(bufoff, h, p) do { if constexpr (GATHER) { PG8_STAGE(bufoff, p, gv[h]); } else { PG8_STAGE(bufoff, (p) + (h) * hstep, voffA); } } while (0)
#define PG8_LDA(dst, b, h) do { _Pragma("unroll") for (int m = 0; m < 4; ++m) _Pragma("unroll") for (int k = 0; k < 2; ++k) dst[m][k] = *(const LAS bf16x8*)(lds + PG8_SA(b, h) + aoff + m * 2048 + k * 1024); } while (0)
#define PG8_LDB(dst, b, h) do { _Pragma("unroll") for (int n = 0; n < 2; ++n) _Pragma("unroll") for (int k = 0; k < 2; ++k) dst[n][k] = *(const LAS bf16x8*)(lds + PG8_SB(b, h) + boff + n * 2048 + k * 1024); } while (0)
#define PG8_MMA(ai, bj, At, Bt) do { __builtin_amdgcn_s_setprio(1); _Pragma("unroll") for (int m = 0; m < 4; ++m) _Pragma("unroll") for (int n = 0; n < 2; ++n) { \
        if constexpr (FP8) { const i32x8 b8_ = __builtin_shufflevector(__builtin_bit_cast(i32x4, Bt[n][0]), __builtin_bit_cast(i32x4, Bt[n][1]), 0, 1, 2, 3, 4, 5, 6, 7); \
                             const i32x8 a8_ = __builtin_shufflevector(__builtin_bit_cast(i32x4, At[m][0]), __builtin_bit_cast(i32x4, At[m][1]), 0, 1, 2, 3, 4, 5, 6, 7); \
                             acc[ai][bj][m][n] = __builtin_amdgcn_mfma_scale_f32_16x16x128_f8f6f4(b8_, a8_, acc[ai][bj][m][n], 0, 0, 0, 127, 0, 127); } \
        else { _Pragma("unroll") for (int k = 0; k < 2; ++k) acc[ai][bj][m][n] = __builtin_amdgcn_mfma_f32_16x16x32_bf16(Bt[n][k], At[m][k], acc[ai][bj][m][n], 0, 0, 0); } } \
        __builtin_amdgcn_s_setprio(0); } while (0)
#define PG8_WAIT_V(n) asm volatile("s_waitcnt vmcnt(" #n ")" ::: "memory")
#define PG8_WAIT_L(n) asm volatile("s_waitcnt lgkmcnt(" #n ")" ::: "memory")
#define PG8_BAR __builtin_amdgcn_s_barrier()
#define PG8_SCHED __builtin_amdgcn_sched_barrier(0)
#define PG8_GOFF(dst, u) do { _Pragma("unroll") for (int _h = 0; _h < 2; ++_h) _Pragma("unroll") for (int _i = 0; _i < 2; ++_i) dst[_h][_i] = S.a_off(u, _h * HALF + RA[_i]) + (unsigned)CA[_i] * 2u; } while (0)
    Unit cur, nxt; int ui = 0;
    if (!S.next(0, cur)) return;
    f32x4 acc[2][2][4][2];
#pragma unroll
    for (int a = 0; a < 2; ++a)
#pragma unroll
        for (int b = 0; b < 2; ++b)
#pragma unroll
            for (int m = 0; m < 4; ++m)
#pragma unroll
                for (int n = 0; n < 2; ++n) acc[a][b][m][n] = (f32x4){0.f, 0.f, 0.f, 0.f};
    bf16x8 At[4][2], B0[2][2], B1[2][2];
    const char* cA = GATHER ? S.A : S.a_ptr(cur); const char* cB = S.b_ptr(cur);
    if constexpr (GATHER) PG8_GOFF(gv, cur);
    PG8_STAGE(PG8_SB(0, 0), cB, voffB); PG8_STAGE_A(PG8_SA(0, 0), 0, cA); PG8_STAGE(PG8_SB(0, 1), cB + hstep, voffB); PG8_STAGE_A(PG8_SA(0, 1), 1, cA);
    if (wr == 1) PG8_BAR;
    PG8_WAIT_V(4); PG8_BAR;
    PG8_STAGE(PG8_SB(1, 0), cB + kstep, voffB); PG8_STAGE_A(PG8_SA(1, 0), 0, cA + kstep); PG8_STAGE(PG8_SB(1, 1), cB + hstep + kstep, voffB);
    PG8_WAIT_V(6); PG8_BAR;
    for (;;) {
        const bool has_next = S.next(ui + 1, nxt);
        const char* nA = GATHER ? S.A : (has_next ? S.a_ptr(nxt) : cA); const char* nB = has_next ? S.b_ptr(nxt) : cB;
        for (int t = 0; t < nt; t += 2) {
            const bool last = (t == nt - 2);
            const char* a1 = cA + (size_t)(t + 1) * kstep;
            const char* a2 = last ? nA : cA + (size_t)(t + 2) * kstep; const char* b2 = last ? nB : cB + (size_t)(t + 2) * kstep;
            const char* a3 = a2 + kstep; const char* b3 = b2 + kstep;
            unsigned nv[2][2];
            if constexpr (GATHER) { if (last && has_next) PG8_GOFF(nv, nxt); }
            PG8_LDB(B0, 0, 0); PG8_SCHED; PG8_LDA(At, 0, 0); PG8_STAGE_A(PG8_SA(1, 1), 1, a1);
            if constexpr (GATHER) { if (last && has_next) { gv[0][0] = nv[0][0]; gv[0][1] = nv[0][1]; gv[1][0] = nv[1][0]; gv[1][1] = nv[1][1]; } }
            PG8_WAIT_L(8); PG8_BAR; PG8_WAIT_L(0); PG8_MMA(0, 0, At, B0); PG8_BAR; PG8_SCHED;
            PG8_LDB(B1, 0, 1); PG8_STAGE(PG8_SB(0, 0), b2, voffB);
            PG8_BAR; PG8_WAIT_L(0); PG8_MMA(0, 1, At, B1); PG8_BAR;
            PG8_LDA(At, 0, 1); PG8_STAGE_A(PG8_SA(0, 0), 0, a2);
            PG8_BAR; PG8_WAIT_L(0); PG8_MMA(1, 0, At, B0); PG8_BAR; PG8_SCHED;
            PG8_STAGE(PG8_SB(0, 1), b2 + hstep, voffB);
            PG8_WAIT_V(6); PG8_BAR; PG8_MMA(1, 1, At, B1); PG8_BAR;
            PG8_LDB(B0, 1, 0); PG8_SCHED; PG8_LDA(At, 1, 0); PG8_STAGE_A(PG8_SA(0, 1), 1, a2);
            PG8_WAIT_L(8); PG8_BAR; PG8_WAIT_L(0); PG8_MMA(0, 0, At, B0); PG8_BAR; PG8_SCHED;
            PG8_LDB(B1, 1, 1); PG8_STAGE(PG8_SB(1, 0), b3, voffB);
            PG8_BAR; PG8_WAIT_L(0); PG8_MMA(0, 1, At, B1); PG8_BAR;
            PG8_LDA(At, 1, 1); PG8_STAGE_A(PG8_SA(1, 0), 0, a3);
            PG8_BAR; PG8_WAIT_L(0); PG8_MMA(1, 0, At, B0); PG8_BAR; PG8_SCHED;
            PG8_STAGE(PG8_SB(1, 1), b3 + hstep, voffB);
            PG8_WAIT_V(6); PG8_BAR; PG8_MMA(1, 1, At, B1); PG8_BAR;
        }
        E(acc, cur, wr, wc, fr, fq);
        if (!has_next) break;
#pragma unroll
        for (int a = 0; a < 2; ++a)
#pragma unroll
            for (int b = 0; b < 2; ++b)
#pragma unroll
                for (int m = 0; m < 4; ++m)
#pragma unroll
                    for (int n = 0; n < 2; ++n) acc[a][b][m][n] = (f32x4){0.f, 0.f, 0.f, 0.f};
        cur = nxt; cA = nA; cB = nB; ++ui;
    }
    PG8_WAIT_V(0);
    if (wr == 0) PG8_BAR;
    PG8_BAR;
#undef PG8_SA
#undef PG8_SB
#undef PG8_STAGE
#undef PG8_STAGE_A
#undef PG8_LDA
#undef PG8_LDB
#undef PG8_MMA
#undef PG8_WAIT_V
#undef PG8_WAIT_L
#undef PG8_BAR
#undef PG8_SCHED
#undef PG8_GOFF
}
}

struct EpiIn {
    bf16_t* z; const float* cosT; const float* sinT;
    __device__ __forceinline__ void operator()(const f32x4 (&acc)[2][2][4][2], const pg8::Unit& u, int wr, int wc, int fr, int fq) const {
        const bool is_x = u.pm < NTOK / 256, anyrope = is_x && u.pn <= 2;
        f32x4 cs[2][4], sn[2][4];
#pragma unroll
        for (int ai = 0; ai < 2; ++ai)
#pragma unroll
            for (int m = 0; m < 4; ++m) {
                const int row = u.pm * 256 + ai * 128 + wr * 64 + m * 16 + fr, s = row & (SEQ - 1), pos = (wc & 1) ? (s & 63) : (s >> 6);
                cs[ai][m] = (f32x4){1.f, 1.f, 1.f, 1.f}; sn[ai][m] = (f32x4){0.f, 0.f, 0.f, 0.f};
                if (anyrope) { cs[ai][m] = *(const f32x4*)(cosT + pos * 16 + 4 * fq); sn[ai][m] = *(const f32x4*)(sinT + pos * 16 + 4 * fq); } }
        asm volatile("" ::: "memory");
#pragma unroll
        for (int ai = 0; ai < 2; ++ai)
#pragma unroll
            for (int m = 0; m < 4; ++m) {
                const int row = u.pm * 256 + ai * 128 + wr * 64 + m * 16 + fr;
                bf16_t* rowp = z + (size_t)row * NIN + u.pn * 256 + wc * 32 + 8 * fq;
#pragma unroll
                for (int bj = 0; bj < 2; ++bj) {
                    const bool rope = is_x && (u.pn < 2 || (u.pn == 2 && bj == 0));
                    const float sc = (u.pn < 2) ? 0.125f * LOG2E : 1.0f;
                    f32x4 v0 = acc[ai][bj][m][0], v1 = acc[ai][bj][m][1];
                    if (rope) { const f32x4 o0 = v0 * cs[ai][m] - v1 * sn[ai][m], o1 = v0 * sn[ai][m] + v1 * cs[ai][m]; v0 = o0; v1 = o1; }
                    v0 = v0 * sc; v1 = v1 * sc;
                    u32x4 w; w.x = cvt_pk_bf16(v0[0], v0[1]); w.y = cvt_pk_bf16(v0[2], v0[3]); w.z = cvt_pk_bf16(v1[0], v1[1]); w.w = cvt_pk_bf16(v1[2], v1[3]);
                    *(u32x4*)(rowp + bj * 128) = w;
                }
            }
    }
};
struct EpiOut {
    const float* x; const float* modf; unsigned char* outb;
    __device__ __forceinline__ void operator()(const f32x4 (&acc)[2][2][4][2], const pg8::Unit& u, int wr, int wc, int fr, int fq) const {
        const int b = (u.pm * 256) / SEQ, col0 = u.pn * 256 + wc * 32 + 8 * fq;
        const float* g1 = modf + b * 6144 + 2 * DM + col0;
        f32x4 gv[2][2];
#pragma unroll
        for (int bj = 0; bj < 2; ++bj) { gv[bj][0] = *(const f32x4*)(g1 + bj * 128); gv[bj][1] = *(const f32x4*)(g1 + bj * 128 + 4); }
#pragma unroll
        for (int ai = 0; ai < 2; ++ai) {
            f32x4 xv[4][2][2];
#pragma unroll
            for (int m = 0; m < 4; ++m)
#pragma unroll
                for (int bj = 0; bj < 2; ++bj) { const float* xr = x + (size_t)(u.pm * 256 + ai * 128 + wr * 64 + m * 16 + fr) * DM + col0 + bj * 128;
                    xv[m][bj][0] = *(const f32x4*)xr; xv[m][bj][1] = *(const f32x4*)(xr + 4); }
            asm volatile("" ::: "memory");
#pragma unroll
            for (int m = 0; m < 4; ++m) {
                const int row = u.pm * 256 + ai * 128 + wr * 64 + m * 16 + fr;
#pragma unroll
                for (int bj = 0; bj < 2; ++bj) {
                    const f32x4 v0 = xv[m][bj][0] + gv[bj][0] * acc[ai][bj][m][0], v1 = xv[m][bj][1] + gv[bj][1] * acc[ai][bj][m][1];
                    u32x4 w; w.x = cvt_pk_bf16(v0[0], v0[1]); w.y = cvt_pk_bf16(v0[2], v0[3]); w.z = cvt_pk_bf16(v1[0], v1[1]); w.w = cvt_pk_bf16(v1[2], v1[3]);
                    *(u32x4*)(outb + (size_t)row * 4096 + (size_t)(col0 + bj * 128) * 2) = w;
                }
            }
            asm volatile("" ::: "memory");
        }
    }
};
struct EpiGU {
    unsigned char* H; int skip;
    __device__ __forceinline__ void operator()(const f32x4 (&acc)[2][2][4][2], const pg8::Unit& u, int wr, int wc, int fr, int fq) const {
        if (skip) return;
#pragma unroll
        for (int ai = 0; ai < 2; ++ai)
#pragma unroll
            for (int m = 0; m < 4; ++m) {
                const size_t row = (size_t)u.pm * 256 + ai * 128 + wr * 64 + m * 16 + fr;
                float h[8];
#pragma unroll
                for (int n = 0; n < 2; ++n)
#pragma unroll
                    for (int j = 0; j < 4; j += 2) {
                        const f32x2 g = (f32x2){acc[ai][0][m][n][j], acc[ai][0][m][n][j + 1]}, up = (f32x2){acc[ai][1][m][n][j], acc[ai][1][m][n][j + 1]};
                        const f32x2 t = g * (-LOG2E / 32.0f); f32x2 e; e.x = __builtin_amdgcn_exp2f(t.x); e.y = __builtin_amdgcn_exp2f(t.y);
                        const f32x2 d = e + 1.0f; f32x2 r; r.x = __builtin_amdgcn_rcpf(d.x); r.y = __builtin_amdgcn_rcpf(d.y);
                        const f32x2 hh = (g * up) * (r * (1.0f / 1024.0f));
                        h[n * 4 + j] = hh.x; h[n * 4 + j + 1] = hh.y; }
                u32x2 w; int pk = 0;
                pk = __builtin_amdgcn_cvt_pk_fp8_f32(h[0], h[1], pk, false); pk = __builtin_amdgcn_cvt_pk_fp8_f32(h[2], h[3], pk, true); w.x = (unsigned)pk;
                pk = __builtin_amdgcn_cvt_pk_fp8_f32(h[4], h[5], pk, false); pk = __builtin_amdgcn_cvt_pk_fp8_f32(h[6], h[7], pk, true); w.y = (unsigned)pk;
                *(u32x2*)(H + row * DEXP + u.pn * 128 + wc * 32 + 8 * fq) = w;
            }
    }
};
struct EpiD {
    unsigned char* Y; const LAS int* cnt; const LAS int* yb; int skip;
    __device__ __forceinline__ void operator()(const f32x4 (&acc)[2][2][4][2], const pg8::Unit& u, int wr, int wc, int fr, int fq) const {
        if (skip) return;
        const int n = cnt[u.e], y0 = yb[u.e];
#pragma unroll
        for (int ai = 0; ai < 2; ++ai)
#pragma unroll
            for (int m = 0; m < 4; ++m) {
                const int slot = u.j * 256 + ai * 128 + wr * 64 + m * 16 + fr;
                if (slot < n) {
                    u32x4 w;
#pragma unroll
                    for (int bj = 0; bj < 2; ++bj)
#pragma unroll
                        for (int nn = 0; nn < 2; ++nn) { f32x4 v = acc[ai][bj][m][nn];
                            int pk = 0; pk = __builtin_amdgcn_cvt_pk_fp8_f32(v[0], v[1], pk, false); pk = __builtin_amdgcn_cvt_pk_fp8_f32(v[2], v[3], pk, true); w[2 * bj + nn] = (unsigned)pk; }
                    *(u32x4*)(Y + (size_t)(y0 + slot) * DM + u.pn * 256 + wc * 64 + 16 * fq) = w;
                }
            }
    }
};


__device__ __forceinline__ void moe_down_run(LAS unsigned char* lds, const unsigned char* Hblk, const unsigned char* Wd, unsigned char* Y, unsigned char* dumprow, int y0, int n, int j0, int m) {
    int tid = threadIdx.x; asm volatile("" : "+v"(tid));
    const int w = __builtin_amdgcn_readfirstlane(tid >> 6), lane = tid & 63, fr = lane & 15, fq = lane >> 4;
    const unsigned lds0 = (unsigned)(size_t)lds;
    i32x8 b8[8][2];
    { const unsigned char* const bp = Wd + (size_t)(w * 128 + fr) * 256 + fq * 32;
#pragma unroll
      for (int cb = 0; cb < 8; ++cb)
#pragma unroll
          for (int ks = 0; ks < 2; ++ks) { const unsigned char* p = bp + cb * 4096 + ks * 128; b8[cb][ks] = __builtin_shufflevector(*(const i32x4*)p, *(const i32x4*)(p + 16), 0, 1, 2, 3, 4, 5, 6, 7); } }
    asm volatile("" ::: "memory");
#define D2_DMAH(k_) do { const unsigned char* const hs_ = Hblk + (size_t)(k_) * 65536; int l2_ = lane; asm volatile("" : "+v"(l2_)); const int fr_ = l2_ & 15, fq_ = l2_ >> 4;     \
        _Pragma("unroll") for (int i = 0; i < 8; ++i) __builtin_amdgcn_global_load_lds((const unsigned*)(hs_ + i * 1024 + (unsigned)(w * 8192 + fq_ * 256 + ((fr_ ^ (4 * (i & 3) + fq_)) << 4))), (LAS unsigned*)(lds + ((k_) & 1) * 65536 + w * 8192 + i * 1024), 16, 0, 0); \
        asm volatile("" ::: "memory"); } while (0)
    D2_DMAH(0);
    const unsigned x00 = (unsigned)(((2 * fq) ^ fr) << 4), rb_ = lds0 + (unsigned)fr * 256u;
    const unsigned la0 = rb_ + x00;
    unsigned char* const ybase = Y + (size_t)y0 * DM + w * 128;
    unsigned char* const dbase = dumprow + w * 128;
    const unsigned fq32 = (unsigned)fq * 32u;
#define D2_RD(F, rb) do { const unsigned o_ = hoff + (unsigned)(rb) * 4096u; \
        asm volatile("ds_read_b128 %0, %4\n\tds_read_b128 %1, %5\n\tds_read_b128 %2, %6\n\tds_read_b128 %3, %7" \
                     : "=&v"(F[0]), "=&v"(F[1]), "=&v"(F[2]), "=&v"(F[3]) : "v"(la0 + o_), "v"((la0 + o_) ^ 16u), "v"((la0 + o_) ^ 128u), "v"((la0 + o_) ^ 144u) : "memory"); __builtin_amdgcn_sched_barrier(0); } while (0)
#define D2_LW(F) __builtin_amdgcn_sched_barrier(0); asm volatile("s_waitcnt lgkmcnt(0)" : "+v"(F[0]), "+v"(F[1]), "+v"(F[2]), "+v"(F[3]) :: "memory")
#define D2_MM(ACC, F) do { const i32x8 a0_ = __builtin_shufflevector(F[0], F[1], 0, 1, 2, 3, 4, 5, 6, 7), a1_ = __builtin_shufflevector(F[2], F[3], 0, 1, 2, 3, 4, 5, 6, 7); \
        _Pragma("unroll") for (int cb = 0; cb < 8; ++cb) ACC[cb] = __builtin_amdgcn_mfma_scale_f32_16x16x128_f8f6f4(b8[cb][0], a0_, (f32x4){0.f, 0.f, 0.f, 0.f}, 0, 0, 0, 127, 0, 127); \
        _Pragma("unroll") for (int cb = 0; cb < 8; ++cb) ACC[cb] = __builtin_amdgcn_mfma_scale_f32_16x16x128_f8f6f4(b8[cb][1], a1_, ACC[cb], 0, 0, 0, 127, 0, 127); } while (0)
#define D2_E(rb, ACC) do { const int slot_ = slot0 + (rb) * 16; const bool ok_ = slot_ < n; unsigned char* const p_ = (ok_ ? ybase : dbase) + ((ok_ ? (size_t)slot_ * DM : (size_t)0) + fq32); u32x4 w0_, w1_; \
        _Pragma("unroll") for (int cb = 0; cb < 4; ++cb) { const f32x4 v_ = ACC[cb]; int pk_ = 0; pk_ = __builtin_amdgcn_cvt_pk_fp8_f32(v_[0], v_[1], pk_, false); pk_ = __builtin_amdgcn_cvt_pk_fp8_f32(v_[2], v_[3], pk_, true); w0_[cb] = (unsigned)pk_; } \
        _Pragma("unroll") for (int cb = 0; cb < 4; ++cb) { const f32x4 v_ = ACC[4 + cb]; int pk_ = 0; pk_ = __builtin_amdgcn_cvt_pk_fp8_f32(v_[0], v_[1], pk_, false); pk_ = __builtin_amdgcn_cvt_pk_fp8_f32(v_[2], v_[3], pk_, true); w1_[cb] = (unsigned)pk_; } \
        *(u32x4*)p_ = w0_; *(u32x4*)(p_ + 16) = w1_; } while (0)
    f32x4 accP[8], accQ[8];
    i32x4 A0[4], A1[4];
#pragma nounroll
    for (int k = 0; k < m; ++k) {
        if (k == 0) asm volatile("s_waitcnt vmcnt(0)" ::: "memory"); else asm volatile("s_waitcnt vmcnt(32)" ::: "memory");
        __builtin_amdgcn_s_barrier();
        if (k + 1 < m) D2_DMAH(k + 1);
        const unsigned hoff = (unsigned)(k & 1) * 65536u;
        const int slot0 = (j0 + k) * 256 + fr;
        D2_RD(A0, 0); D2_LW(A0);
        D2_RD(A1, 1); D2_MM(accP, A0); D2_LW(A1);
#pragma nounroll
        for (int rb = 0; rb < 14; rb += 2) {
            D2_RD(A0, rb + 2); D2_MM(accQ, A1); D2_E(rb, accP); D2_LW(A0);
            D2_RD(A1, rb + 3); D2_MM(accP, A0); D2_E(rb + 1, accQ); D2_LW(A1);
        }
        D2_MM(accQ, A1); D2_E(14, accP); D2_E(15, accQ);
    }
    __builtin_amdgcn_s_barrier();
#undef D2_DMAH
#undef D2_RD
#undef D2_LW
#undef D2_MM
#undef D2_E
}

struct Args { const float* in[22]; float* out; unsigned char* ws; int ph_lo, ph_hi; };

__device__ __forceinline__ int mapd64(int c) { const int p = c & 127; return (c & ~127) + 16 * ((p >> 2) & 7) + 4 * (p >> 5) + (p & 3); }
__device__ __forceinline__ int map16(int p) { return 128 * ((p >> 3) & 1) + 16 * ((p >> 2) & 1) + 4 * ((p >> 4) & 1) + (p & 3); }
__device__ __forceinline__ void transpose_item(const float* W, int ldw, int k0, int n0, bf16_t* dst, int ldd, int rowbase, int perm, LAS float* scr, int lane, float wscale = 1.0f) {
    f32x4 v[8];
#pragma unroll
    for (int i = 0; i < 8; ++i) v[i] = *(const f32x4*)(W + (size_t)(k0 + 8 * i + (lane >> 3)) * ldw + n0 + 4 * (lane & 7));
#pragma unroll
    for (int i = 0; i < 8; ++i) { LAS float* d = scr + (8 * i + (lane >> 3)) * 33 + 4 * (lane & 7); d[0] = v[i][0] * wscale; d[1] = v[i][1] * wscale; d[2] = v[i][2] * wscale; d[3] = v[i][3] * wscale; }
    LDS_WAIT();
    const int c = lane & 7;
#pragma unroll
    for (int j = 0; j < 4; ++j) { const int n = (lane >> 3) + 8 * j; const LAS float* s = scr + (8 * c) * 33 + n;
        u32x4 o; o.x = cvt_pk_bf16(s[0 * 33], s[1 * 33]); o.y = cvt_pk_bf16(s[2 * 33], s[3 * 33]); o.z = cvt_pk_bf16(s[4 * 33], s[5 * 33]); o.w = cvt_pk_bf16(s[6 * 33], s[7 * 33]);
        const int drow = rowbase + (perm == 2 ? map16(n) : (perm ? invperm32(n) : n));
        *(u32x4*)(dst + (size_t)drow * ldd + k0 + 8 * c) = o; }
    LDS_WAIT();
}

__device__ __forceinline__ void transpose_fin8(const f32x4 (&v)[8], int k0, unsigned char* dst, int ldd, int rowbase, int perm, LAS float* scr, int lane, float wscale) {
#pragma unroll
    for (int i = 0; i < 8; ++i) { LAS float* d = scr + (8 * i + (lane >> 3)) * 33 + 4 * (lane & 7); d[0] = v[i][0] * wscale; d[1] = v[i][1] * wscale; d[2] = v[i][2] * wscale; d[3] = v[i][3] * wscale; }
    LDS_WAIT();
    const int c4 = lane & 3;
#pragma unroll
    for (int j = 0; j < 2; ++j) { const int n = (lane >> 2) + 16 * j; const LAS float* sp = scr + (16 * c4) * 33 + n;
        u32x4 o;
#pragma unroll
        for (int q = 0; q < 4; ++q) { int pk = 0;
            pk = __builtin_amdgcn_cvt_pk_fp8_f32(sp[(4 * q + 0) * 33], sp[(4 * q + 1) * 33], pk, false);
            pk = __builtin_amdgcn_cvt_pk_fp8_f32(sp[(4 * q + 2) * 33], sp[(4 * q + 3) * 33], pk, true);
            o[q] = (unsigned)pk; }
        const int drow = perm == 3 ? mapd64(rowbase + n) : rowbase + (perm == 2 ? map16(n) : (perm ? invperm32(n) : n));
        *(u32x4*)(dst + (size_t)drow * ldd + k0 + 16 * c4) = o; }
    LDS_WAIT();
}
__device__ __forceinline__ void transpose_item8(const float* W, int ldw, int k0, int n0, unsigned char* dst, int ldd, int rowbase, int perm, LAS float* scr, int lane, float wscale) {
    f32x4 v0[8], v1[8];
#pragma unroll
    for (int i = 0; i < 8; ++i) v0[i] = *(const f32x4*)(W + (size_t)(k0 + 8 * i + (lane >> 3)) * ldw + n0 + 4 * (lane & 7));
#pragma unroll
    for (int i = 0; i < 8; ++i) v1[i] = *(const f32x4*)(W + (size_t)(k0 + 64 + 8 * i + (lane >> 3)) * ldw + n0 + 4 * (lane & 7));
    transpose_fin8(v0, k0, dst, ldd, rowbase, perm, scr, lane, wscale);
    transpose_fin8(v1, k0 + 64, dst, ldd, rowbase, perm, scr, lane, wscale);
}

constexpr int I_FOLD = 4 * 8 * 16, I_ROPE = 32, I_WIN = 16 * 24, I_WOUT = 16 * 32, I_WR = 16 * 2, I_E = NEXP1 * 64;
constexpr int NITEMS = I_FOLD + I_ROPE + I_WIN + I_WOUT + I_WR + 3 * I_E;
constexpr int P2_UNITS = (NTOK / 256) * (NIN / 256) + NCTX / 256, P2_IPW = 3;
struct P0Split { int c0, nidle, moved; };
__device__ __forceinline__ P0Split p0_split(int G) {
    P0Split r; const int maxu = (P2_UNITS + G - 1) / G; r.c0 = P2_UNITS - (maxu - 1) * G; r.nidle = r.c0 < G ? G - r.c0 : 0;
    int mv = r.nidle * NWAVES * P2_IPW; r.moved = mv < I_E ? mv : I_E; return r;
}
__device__ __forceinline__ void down_item(int r, const float* w_down, const float* ws_down, bf16_t* WdT, LAS float* scr, int lane) {
    const int e = r >> 6, q = r & 63, kb = q >> 5, n0 = (q & 31) * 32;
    const float* src = (e < NEXP) ? w_down + (size_t)e * DEXP * DM : ws_down;
    transpose_item8(src, DM, kb * 128, n0, (unsigned char*)WdT + (size_t)e * DM * DEXP, DEXP, n0, 3, scr, lane, 16.0f);
}

template <int W, int T> __device__ __forceinline__ void pool4(const bf16_t* zp, int s, bf16_t* op) {
    u32x4 row[W + T - 1];
#pragma unroll
    for (int j = 0; j < W + T - 1; ++j) { const int s2 = s - W / 2 + j; const bool ok = s2 >= 0 && s2 < SEQ; row[j] = ok ? *(const u32x4*)(zp + (size_t)(ok ? s2 : s) * NIN) : (u32x4){0u, 0u, 0u, 0u}; }
    float sum[8];
#pragma unroll
    for (int c = 0; c < 8; ++c) sum[c] = 0.f;
#pragma unroll
    for (int j = 0; j < W; ++j) { sum[0] += bf_lo(row[j].x); sum[1] += bf_hi(row[j].x); sum[2] += bf_lo(row[j].y); sum[3] += bf_hi(row[j].y); sum[4] += bf_lo(row[j].z); sum[5] += bf_hi(row[j].z); sum[6] += bf_lo(row[j].w); sum[7] += bf_hi(row[j].w); }
#pragma unroll
    for (int i = 0; i < T; ++i) {
        int lo_ = s + i - W / 2, hi_ = lo_ + W; lo_ = lo_ < 0 ? 0 : lo_; hi_ = hi_ > SEQ ? SEQ : hi_;
        const float inv = 1.0f / (float)(hi_ - lo_);
        const u32x4 sv = row[i + W / 2];
        u32x4 o;
        o.x = cvt_pk_bf16(sum[0] * inv - bf_lo(sv.x), sum[1] * inv - bf_hi(sv.x)); o.y = cvt_pk_bf16(sum[2] * inv - bf_lo(sv.y), sum[3] * inv - bf_hi(sv.y));
        o.z = cvt_pk_bf16(sum[4] * inv - bf_lo(sv.z), sum[5] * inv - bf_hi(sv.z)); o.w = cvt_pk_bf16(sum[6] * inv - bf_lo(sv.w), sum[7] * inv - bf_hi(sv.w));
        *(u32x4*)(op + (size_t)i * DM) = o;
        if (i < T - 1) { const u32x4 a = row[i], b = row[i + W];
            sum[0] += bf_lo(b.x) - bf_lo(a.x); sum[1] += bf_hi(b.x) - bf_hi(a.x); sum[2] += bf_lo(b.y) - bf_lo(a.y); sum[3] += bf_hi(b.y) - bf_hi(a.y);
            sum[4] += bf_lo(b.z) - bf_lo(a.z); sum[5] += bf_hi(b.z) - bf_hi(a.z); sum[6] += bf_lo(b.w) - bf_lo(a.w); sum[7] += bf_hi(b.w) - bf_hi(a.w); }
    }
}

__device__ __forceinline__ const void* ldp(volatile LAS unsigned* ptab, int k) {
    const unsigned lo = __builtin_amdgcn_readfirstlane(ptab[2 * k]), hi = __builtin_amdgcn_readfirstlane(ptab[2 * k + 1]);
    return (const void*)(const __attribute__((address_space(1))) char*)(((unsigned long long)hi << 32) | lo);
}

__global__ void __launch_bounds__(NTHREADS, 2) fwd(Args args) {
    extern __shared__ __attribute__((aligned(16))) unsigned char lds_raw[];
    LAS unsigned char* lds = (LAS unsigned char*)lds_raw;
    const int tid_k = threadIdx.x;
    const int G = gridDim.x, bid = blockIdx.x, NGW = G * NWAVES;
    const int vb = (G % 8 == 0) ? (bid % 8) * (G / 8) + bid / 8 : bid;
    LAS int* l_tb = (LAS int*)(lds + L_TB); LAS int* l_cnt = (LAS int*)(lds + L_CNT); LAS int* l_yb = (LAS int*)(lds + L_YB);
    LAS int* l_hist = (LAS int*)(lds + L_HIST); LAS int* l_base = (LAS int*)(lds + L_BASE);

    for (int u = tid_k; u < (LDS_BYTES - STAGE_BYTES) / 4; u += NTHREADS) ((LAS unsigned*)(lds + STAGE_BYTES))[u] = 0u;
    __syncthreads();
    volatile LAS unsigned* ptab = (volatile LAS unsigned*)(lds + L_PTR);
    if (tid_k < 24) { const unsigned long long pv = (tid_k < 22) ? (unsigned long long)args.in[tid_k] : (tid_k == 22 ? (unsigned long long)args.out : (unsigned long long)args.ws); ptab[2 * tid_k] = (unsigned)pv; ptab[2 * tid_k + 1] = (unsigned)(pv >> 32); }
    __syncthreads();
    asm volatile("s_setreg_imm32_b32 hwreg(HW_REG_MODE, 23, 1), 1");
    if (!MK_PER_PHASE) (void)xcd_barrier_post((unsigned*)(args.ws + WS_CTL + CTL_BAR), (volatile LAS unsigned*)(lds + L_MISC) + 8);
#if MK_PER_PHASE
    const int lo = args.ph_lo, hi = args.ph_hi;
#define IN(k) (lo <= (k) && (k) < hi)
#define SEAM(k) do { if (IN(k) && IN((k) + 1)) { XcdBarrier b_; b_.bar = (unsigned*)((unsigned char*)ldp(ptab, 23) + (WS_CTL + CTL_BAR)); b_.x = xb_xcc_id(); b_.st = (volatile LAS unsigned*)(lds + L_MISC) + 8; xcd_barrier(b_); } } while (0)
#else
#define IN(k) true
#define SEAM(k) do { XcdBarrier b_; b_.bar = (unsigned*)((unsigned char*)ldp(ptab, 23) + (WS_CTL + CTL_BAR)); b_.x = xb_xcc_id(); b_.st = (volatile LAS unsigned*)(lds + L_MISC) + 8; xcd_barrier(b_); } while (0)
#endif

    if (IN(0)) {
        int tid = tid_k; asm volatile("" : "+v"(tid)); const int lane = tid & 63, wave = __builtin_amdgcn_readfirstlane(tid >> 6), gw = bid * NWAVES + wave; (void)lane; (void)gw;
        const float* const w_ada = (const float*)ldp(ptab, 4);
        const float* const cvec = (const float*)ldp(ptab, 1);
        const float* const c_ctx = (const float*)ldp(ptab, 3);
        const float* const b_ada = (const float*)ldp(ptab, 5);
        float* const modf = (float*)((unsigned char*)ldp(ptab, 23) + (WS_MODF));
        const float* const w_in = (const float*)ldp(ptab, 8);
        const float* const pool_w = (const float*)ldp(ptab, 10);
        const float* const pool_scale = (const float*)ldp(ptab, 11);
        bf16_t* const WinT = (bf16_t*)((unsigned char*)ldp(ptab, 23) + (WS_WIN));
        float* const cosT = (float*)((unsigned char*)ldp(ptab, 23) + (WS_ROPE));
        float* const sinT = (float*)((unsigned char*)ldp(ptab, 23) + (WS_ROPE + 128 * 16 * 4));
        const float* const w_out = (const float*)ldp(ptab, 12);
        bf16_t* const WoutT = (bf16_t*)((unsigned char*)ldp(ptab, 23) + (WS_WOUT));
        const float* const w_router = (const float*)ldp(ptab, 13);
        bf16_t* const WrT = (bf16_t*)((unsigned char*)ldp(ptab, 23) + (WS_WR));
        const float* const w_gate = (const float*)ldp(ptab, 15);
        const float* const w_up = (const float*)ldp(ptab, 16);
        const float* const ws_gate = (const float*)ldp(ptab, 18);
        const float* const ws_up = (const float*)ldp(ptab, 19);
        bf16_t* const WguT = (bf16_t*)((unsigned char*)ldp(ptab, 23) + (WS_WGU));
        const float* const w_down = (const float*)ldp(ptab, 17);
        const float* const ws_down = (const float*)ldp(ptab, 20);
        bf16_t* const WdT = (bf16_t*)((unsigned char*)ldp(ptab, 23) + (WS_WD));
        LAS float* scr = (LAS float*)(lds + wave * 16384);
        for (int cb = bid; cb < 6144 / 32; cb += G) {
            LAS float* part = (LAS float*)lds;
            LAS float* sil = (LAS float*)(lds + 16384);
            const int col = cb * 32 + (lane & 31), ksub = wave * 2 + (lane >> 5);
            float wv[64];
#pragma unroll
            for (int kk = 0; kk < 64; ++kk) wv[kk] = w_ada[(size_t)(ksub * 64 + kk) * 6144 + col];
            { float cv[5 * DM / NTHREADS];
#pragma unroll
              for (int j = 0; j < 5 * DM / NTHREADS; ++j) { const int i = tid + j * NTHREADS; cv[j] = (i < 4 * DM) ? cvec[i] : c_ctx[i - 4 * DM]; }
#pragma unroll
              for (int j = 0; j < 5 * DM / NTHREADS; ++j) sil[tid + j * NTHREADS] = cv[j] / (1.0f + __expf(-cv[j])); }
            __syncthreads();
            float a5[5] = {0.f, 0.f, 0.f, 0.f, 0.f};
#pragma unroll
            for (int kk = 0; kk < 64; ++kk) {
#pragma unroll
                for (int q = 0; q < 5; ++q) a5[q] += sil[q * DM + ksub * 64 + kk] * wv[kk]; }
#pragma unroll
            for (int q = 0; q < 5; ++q) part[(ksub * 5 + q) * 32 + (lane & 31)] = a5[q];
            __syncthreads();
            if (tid < 160) { const int q = tid >> 5, c = tid & 31; float sacc = 0.f;
#pragma unroll
                for (int ks = 0; ks < 16; ++ks) sacc += part[(ks * 5 + q) * 32 + c];
                modf[q * 6144 + cb * 32 + c] = sacc + b_ada[cb * 32 + c]; }
            VM_WAIT();
            __syncthreads();
            if (tid == 0) { __builtin_amdgcn_fence(__ATOMIC_RELEASE, "agent"); asm volatile("s_waitcnt vmcnt(0)" ::: "memory");
                __hip_atomic_fetch_add((unsigned*)((unsigned char*)ldp(ptab, 23) + (WS_CTL + CTL_ADA)), 1u, __ATOMIC_RELAXED, __HIP_MEMORY_SCOPE_AGENT); }
        }
        const int moved = p0_split(G).moved;
        const bool tail_fold = NGW >= I_FOLD;
        const int nrest = tail_fold ? NITEMS - I_FOLD : NITEMS, roff = tail_fold ? I_FOLD : 0;
        for (int n = tail_fold ? -1 : 0; ; ++n) {
            int r;
            if (n < 0) { r = NGW - 1 - gw; if (r >= I_FOLD) continue; }
            else { const int j = gw + n * NGW; if (j >= nrest - moved) break; r = roff + j; }
            if (r < I_FOLD) {
                const int g = r >> 7, dblk = (r >> 4) & 7, kblk = r & 15, k = kblk * 64 + lane;
                float a16[16];
#pragma unroll
                for (int d = 0; d < 16; ++d) a16[d] = 0.f;
                const float* wrow = w_in + (size_t)k * NIN + 768 + g * 128; const float* pw = pool_w + (size_t)g * 128 * 128 + dblk * 16;
                f32x4 wv4[32], pwl[8];
#pragma unroll
                for (int i = 0; i < 32; ++i) wv4[i] = *(const f32x4*)(wrow + 4 * i);
#pragma unroll
                for (int i = 0; i < 8; ++i) { const int idx = i * 64 + lane; pwl[i] = *(const f32x4*)(pw + (idx >> 2) * 128 + 4 * (idx & 3)); }
#pragma unroll
                for (int i = 0; i < 8; ++i) *(LAS f32x4*)(scr + 4 * (i * 64 + lane)) = pwl[i];
                LDS_WAIT();
#pragma unroll
                for (int i = 0; i < 32; ++i)
#pragma unroll
                    for (int j = 0; j < 4; ++j) { const int c = 4 * i + j; const float a = wv4[i][j];
#pragma unroll
                        for (int dq = 0; dq < 4; ++dq) { const f32x4 p4 = *(const LAS f32x4*)(scr + c * 16 + 4 * dq);
                            a16[4 * dq + 0] += a * p4[0]; a16[4 * dq + 1] += a * p4[1]; a16[4 * dq + 2] += a * p4[2]; a16[4 * dq + 3] += a * p4[3]; } }
                LDS_WAIT();
#pragma unroll
                for (int d = 0; d < 16; ++d) { const int np = g * 128 + dblk * 16 + d; const int drow = 768 + (np & ~31) + invperm32(np & 31);
                    WinT[(size_t)drow * DM + k] = (bf16_t)(cvt_pk_bf16(a16[d] * pool_scale[np], 0.f) & 0xffffu); }
                continue; } r -= I_FOLD;
            if (r < I_ROPE) { const int en = r * 64 + lane, pos = en >> 4, d = en & 15; const float inv = powf(10000.0f, -(float)d / 16.0f), ang = (float)pos * inv;
                cosT[en] = cosf(ang); sinT[en] = sinf(ang); continue; } r -= I_ROPE;
            if (r < I_WIN) { const int kb = r / 24, nbk = r % 24, n0 = nbk * 32; transpose_item(w_in, NIN, kb * 64, n0, WinT, DM, n0, n0 >= 640, scr, lane); continue; } r -= I_WIN;
            if (r < I_WOUT) { const int kb = r >> 5, n0 = (r & 31) * 32; transpose_item(w_out, DM, kb * 64, n0, WoutT, DM, n0, true, scr, lane); continue; } r -= I_WOUT;
            if (r < I_WR) { const int kb = r >> 1, n0 = (r & 1) * 32; transpose_item(w_router, NEXP, kb * 64, n0, WrT, DM, n0, false, scr, lane); continue; } r -= I_WR;
            if (r < 2 * I_E) {
                const int up = r >= I_E; if (up) r -= I_E;
                const int e = r >> 6, q = r & 63, kb = q >> 3, n0 = (q & 7) * 32;
                const float* src = (e < NEXP) ? (up ? w_up : w_gate) + (size_t)e * DM * DEXP : (up ? ws_up : ws_gate);
                transpose_item8(src, DEXP, kb * 128, n0, (unsigned char*)WguT + (size_t)e * 512 * DM, DM, 256 * (n0 >> 7) + 128 * up + (n0 & 127), 1, scr, lane, 32.0f); continue; } r -= 2 * I_E;
            down_item(r, w_down, ws_down, WdT, scr, lane);
        }
    }
#if MK_PER_PHASE
    SEAM(0);
#else
    {
        if (tid_k == 0) { unsigned* const cnt_ada = (unsigned*)((unsigned char*)ldp(ptab, 23) + (WS_CTL + CTL_ADA)); unsigned sp = 0;
            while (__hip_atomic_load(cnt_ada, __ATOMIC_RELAXED, __HIP_MEMORY_SCOPE_AGENT) < 6144u / 32u) { __builtin_amdgcn_s_sleep(2); if (++sp > (1u << 22)) break; }
            __builtin_amdgcn_fence(__ATOMIC_ACQUIRE, "agent"); asm volatile("s_waitcnt vmcnt(0)" ::: "memory"); }
        __syncthreads();
    }
#endif

    if (IN(1)) {
        int tid = tid_k; asm volatile("" : "+v"(tid)); const int lane = tid & 63, wave = __builtin_amdgcn_readfirstlane(tid >> 6), gw = bid * NWAVES + wave; (void)lane; (void)gw;
        const float* const x_in = (const float*)ldp(ptab, 0);
        const float* const ctx = (const float*)ldp(ptab, 2);
        const float* const norm1_g = (const float*)ldp(ptab, 6);
        float* const modf = (float*)((unsigned char*)ldp(ptab, 23) + (WS_MODF));
        bf16_t* const hx = (bf16_t*)((unsigned char*)ldp(ptab, 23) + (WS_HX));
        const bool hasc = gw < NCTX;
        f32x4 cv[4], cga[4], csh[4];
        if (hasc) { const f32x4* xr = (const f32x4*)(ctx + (size_t)gw * DM) + lane;
#pragma unroll
            for (int j = 0; j < 4; ++j) { const int col = 4 * lane + 256 * j; cv[j] = xr[64 * j];
                cga[j] = *(const f32x4*)(norm1_g + col) * (*(const f32x4*)(modf + 4 * 6144 + DM + col) + 1.0f); csh[j] = *(const f32x4*)(modf + 4 * 6144 + col); } }
        for (int rb = gw; rb < NTOK / 16 + NCTX; rb += NGW) {
            const bool isx = rb < NTOK / 16; const int m0 = isx ? rb * 16 : NTOK + (rb - NTOK / 16), nrow = isx ? 16 : 1, q = isx ? m0 / SEQ : 4;
            if (!isx && rb - NTOK / 16 == gw) continue;
            f32x4 ga[4], sha[4];
#pragma unroll
            for (int j = 0; j < 4; ++j) { const int col = 4 * lane + 256 * j;
                ga[j] = *(const f32x4*)(norm1_g + col) * (*(const f32x4*)(modf + q * 6144 + DM + col) + 1.0f); sha[j] = *(const f32x4*)(modf + q * 6144 + col); }
#pragma unroll 4
            for (int r = 0; r < nrow; ++r) {
                const int m = m0 + r;
                const float* src = (m < NTOK) ? x_in + (size_t)m * DM : ctx + (size_t)(m - NTOK) * DM;
                const f32x4* xr = (const f32x4*)src + lane;
                f32x4 v[4]; float ss = 0.f;
#pragma unroll
                for (int j = 0; j < 4; ++j) { v[j] = xr[64 * j]; ss += (v[j].x * v[j].x + v[j].y * v[j].y) + (v[j].z * v[j].z + v[j].w * v[j].w); }
                const float rstd = rsqrtf(wave_sum(ss) * (1.f / DM) + EPS);
                unsigned long long* o8 = (unsigned long long*)(hx + (size_t)m * DM) + lane;
#pragma unroll
                for (int j = 0; j < 4; ++j) { const f32x4 h = (v[j] * rstd) * ga[j] + sha[j];
                    o8[64 * j] = (unsigned long long)cvt_pk_bf16(h.x, h.y) | ((unsigned long long)cvt_pk_bf16(h.z, h.w) << 32); }
            }
        }
        if (hasc) { float ss = 0.f;
#pragma unroll
            for (int j = 0; j < 4; ++j) ss += (cv[j].x * cv[j].x + cv[j].y * cv[j].y) + (cv[j].z * cv[j].z + cv[j].w * cv[j].w);
            const float rstd = rsqrtf(wave_sum(ss) * (1.f / DM) + EPS);
            unsigned long long* o8 = (unsigned long long*)(hx + (size_t)(NTOK + gw) * DM) + lane;
#pragma unroll
            for (int j = 0; j < 4; ++j) { const f32x4 h = (cv[j] * rstd) * cga[j] + csh[j];
                o8[64 * j] = (unsigned long long)cvt_pk_bf16(h.x, h.y) | ((unsigned long long)cvt_pk_bf16(h.z, h.w) << 32); } }
    }
    SEAM(1);

    if (IN(2)) {
        int tid = tid_k; asm volatile("" : "+v"(tid)); const int lane = tid & 63, wave = __builtin_amdgcn_readfirstlane(tid >> 6), gw = bid * NWAVES + wave; (void)lane; (void)gw;
        bf16_t* const hx = (bf16_t*)((unsigned char*)ldp(ptab, 23) + (WS_HX));
        bf16_t* const WinT = (bf16_t*)((unsigned char*)ldp(ptab, 23) + (WS_WIN));
        bf16_t* const zb = (bf16_t*)((unsigned char*)ldp(ptab, 23) + (WS_Z));
        float* const cosT = (float*)((unsigned char*)ldp(ptab, 23) + (WS_ROPE));
        float* const sinT = (float*)((unsigned char*)ldp(ptab, 23) + (WS_ROPE + 128 * 16 * 4));
        pg8::SchedStatic S; S.nM = NTOK / 256; S.nN = NIN / 256; S.nwg = S.nM * S.nN; S.G = G; S.c = bid; S.extra = NCTX / 256; S.extra_pn = 2; S.A = (const char*)hx; S.Bt = (const char*)WinT; S.K = DM;
        EpiIn E{zb, cosT, sinT};
        pg8::gemm_phase<EpiIn, pg8::SchedStatic, false>(lds, S, E);
        { const P0Split sp = p0_split(G);
          if (bid >= sp.c0) {
            const float* const w_down = (const float*)ldp(ptab, 17);
            const float* const ws_down = (const float*)ldp(ptab, 20);
            bf16_t* const WdT = (bf16_t*)((unsigned char*)ldp(ptab, 23) + (WS_WD));
            LAS float* scr = (LAS float*)(lds + wave * 16384);
            const bool tail_fold = NGW >= I_FOLD; const int nrest = tail_fold ? NITEMS - I_FOLD : NITEMS, roff = tail_fold ? I_FOLD : 0;
            for (int j = nrest - sp.moved + (bid - sp.c0) * NWAVES + wave; j < nrest; j += sp.nidle * NWAVES)
                down_item(roff + j - (I_FOLD + I_ROPE + I_WIN + I_WOUT + I_WR + 2 * I_E), w_down, ws_down, WdT, scr, lane);
          } }
    }
    SEAM(2);

    if (IN(3)) {
        int tid = tid_k; asm volatile("" : "+v"(tid)); const int lane = tid & 63, wave = __builtin_amdgcn_readfirstlane(tid >> 6), gw = bid * NWAVES + wave; (void)lane; (void)gw;
        bf16_t* const zb = (bf16_t*)((unsigned char*)ldp(ptab, 23) + (WS_Z));
        const float* const attn_sink = (const float*)ldp(ptab, 9);
        bf16_t* const mix = (bf16_t*)((unsigned char*)ldp(ptab, 23) + (WS_MIX));
        constexpr int KS = 144;
        LAS unsigned char* kbuf = lds; LAS unsigned char* vbuf = lds + 3 * 64 * KS;
        const int quad = lane >> 4, l15 = lane & 15;
          for (int un = vb; un < NB * 64 * 2; un += G) {
            const int b = un >> 7, nblk = (un & 127) >> 1, kh = un & 1;
            const int hq = kh * 4 + (wave >> 1), qw0 = nblk * 128 + (wave & 1) * 64;
            LAS unsigned char* const qbase = lds + 6 * 64 * KS + wave * (64 * KS);
            { const int qr = lane >> 3, qc = lane & 7;
#pragma unroll
              for (int i = 0; i < 8; ++i) { const u32x4 qv = *(const u32x4*)(zb + (size_t)(b * SEQ + qw0 + 8 * i + qr) * NIN + hq * 64 + 8 * qc);
                *(LAS u32x4*)(qbase + (8 * i + qr) * KS + qc * 16) = qv; } }
            f32x4 O[4][4]; float mrun[4], lrun[4];
            const float sk = attn_sink[hq] * LOG2E;
#pragma unroll
            for (int qb = 0; qb < 4; ++qb) { mrun[qb] = sk; lrun[qb] = quad ? 0.0f : 1.0f;
#pragma unroll
                for (int db = 0; db < 4; ++db) O[db][qb] = (f32x4){0.f, 0.f, 0.f, 0.f}; }
            const int kstart = nblk * 128 - 128 < 0 ? 0 : nblk * 128 - 128, kend = nblk * 128 + 256 > SEQ ? SEQ : nblk * 128 + 256;
            const int ntile = 4 + (kend - kstart) / 64;
            const int lr = tid >> 3, lc = tid & 7;
            u32x4 kreg, vreg;
            { const size_t rowb = (size_t)(NTOK + b * CTXL + lr);
              kreg = *(const u32x4*)(zb + rowb * NIN + 512 + kh * 64 + 8 * lc); vreg = *(const u32x4*)(zb + rowb * NIN + 640 + kh * 64 + 8 * lc); }
            *(LAS u32x4*)(kbuf + lr * KS + lc * 16) = kreg; *(LAS u32x4*)(vbuf + lr * KS + lc * 16) = vreg;
            __syncthreads();
            const bool lagpv = wave >= 4;
            bf16x8 pf[4][2]; bool pend = false; int pbuf = 0;
#define LOAD_VFR(dst, ks, vt_) do { _Pragma("unroll") for (int db = 0; db < 4; ++db) { \
                            const LAS unsigned char* va = (vt_) + (32 * (ks) + 4 * quad + (l15 >> 2)) * KS + (16 * db + 4 * (l15 & 3)) * 2; \
                            const s16x4 v0 = __builtin_amdgcn_ds_read_tr16_b64_v4i16((LAS s16x4*)va); \
                            const s16x4 v1 = __builtin_amdgcn_ds_read_tr16_b64_v4i16((LAS s16x4*)(va + 16 * KS)); \
                            dst[db] = __builtin_shufflevector(v0, v1, 0, 1, 2, 3, 4, 5, 6, 7); } } while (0)
#define ATT_PV(vt_) do { { bf16x8 vfr0[4]; LOAD_VFR(vfr0, 0, vt_); __builtin_amdgcn_sched_barrier(0); __builtin_amdgcn_s_setprio(1); \
                    _Pragma("unroll") for (int db = 0; db < 4; ++db) _Pragma("unroll") for (int qb = 0; qb < 4; ++qb) O[db][qb] = __builtin_amdgcn_mfma_f32_16x16x32_bf16(vfr0[db], pf[qb][0], O[db][qb], 0, 0, 0); } \
                    __builtin_amdgcn_sched_barrier(0); \
                    { bf16x8 vfr1[4]; LOAD_VFR(vfr1, 1, vt_); __builtin_amdgcn_sched_barrier(0); \
                    _Pragma("unroll") for (int db = 0; db < 4; ++db) _Pragma("unroll") for (int qb = 0; qb < 4; ++qb) O[db][qb] = __builtin_amdgcn_mfma_f32_16x16x32_bf16(vfr1[db], pf[qb][1], O[db][qb], 0, 0, 0); __builtin_amdgcn_s_setprio(0); } } while (0)
            for (int it = 0; it < ntile; ++it) {
                const int cb = it - 3 * (it / 3);
                if (lagpv && pend) { ATT_PV(vbuf + pbuf * 64 * KS); pend = false; }
                if (it + 1 < ntile) { const int i2 = it + 1;
                    const size_t rowb = (i2 < 4) ? (size_t)(NTOK + b * CTXL + i2 * 64 + lr) : (size_t)(b * SEQ + kstart + (i2 - 4) * 64 + lr);
                    kreg = *(const u32x4*)(zb + rowb * NIN + 512 + kh * 64 + 8 * lc); vreg = *(const u32x4*)(zb + rowb * NIN + 640 + kh * 64 + 8 * lc); }
                const int k0 = kstart + (it - 4) * 64;
                const bool active = (it < 4) || (k0 <= qw0 + 63 + 128 && k0 + 63 >= qw0 - 128);
                const bool needmask = (it >= 4) && !(k0 >= qw0 + 63 - 128 && k0 + 63 <= qw0 + 128);
                if (active) {
                    const LAS unsigned char* kt = kbuf + cb * 64 * KS; const LAS unsigned char* vt = vbuf + cb * 64 * KS;
                    f32x4 St[4][4];
                    { bf16x8 kf[4][2];
#pragma unroll
                      for (int kb = 0; kb < 4; ++kb)
#pragma unroll
                        for (int ks = 0; ks < 2; ++ks) kf[kb][ks] = *(const LAS bf16x8*)(kt + (16 * kb + l15) * KS + (32 * ks + 8 * quad) * 2);
                      __builtin_amdgcn_s_setprio(1);
#pragma unroll
                      for (int qb = 0; qb < 4; ++qb) { const LAS unsigned char* qa = qbase + (16 * qb + l15) * KS + 16 * quad;
                        const bf16x8 q0 = *(const LAS bf16x8*)qa, q1 = *(const LAS bf16x8*)(qa + 64);
#pragma unroll
                        for (int kb = 0; kb < 4; ++kb) St[kb][qb] = __builtin_amdgcn_mfma_f32_16x16x32_bf16(kf[kb][0], q0, (f32x4){0.f, 0.f, 0.f, 0.f}, 0, 0, 0);
#pragma unroll
                        for (int kb = 0; kb < 4; ++kb) St[kb][qb] = __builtin_amdgcn_mfma_f32_16x16x32_bf16(kf[kb][1], q1, St[kb][qb], 0, 0, 0); }
                      __builtin_amdgcn_s_setprio(0);
                    }
                    if (needmask) {
                        const int lv = 4 * quad - l15; const float ninf = -__builtin_inff();
                        if (k0 < qw0) {
#pragma unroll
                            for (int kb = 0; kb < 4; ++kb)
#pragma unroll
                                for (int qb = 0; qb < 4; ++qb) {
                                    if (qb > kb) St[kb][qb] = (f32x4){ninf, ninf, ninf, ninf};
                                    else if (qb == kb) {
#pragma unroll
                                        for (int r = 0; r < 4; ++r) if (lv < -r) St[kb][qb][r] = ninf; } }
                        } else {
#pragma unroll
                            for (int kb = 0; kb < 4; ++kb)
#pragma unroll
                                for (int qb = 0; qb < 4; ++qb) {
                                    if (kb > qb) St[kb][qb] = (f32x4){ninf, ninf, ninf, ninf};
                                    else if (qb == kb) {
#pragma unroll
                                        for (int r = 0; r < 4; ++r) if (lv > -r) St[kb][qb][r] = ninf; } }
                        }
                    }
#pragma unroll
                    for (int qb = 0; qb < 4; ++qb) {
                        float mx = -__builtin_inff();
#pragma unroll
                        for (int kb = 0; kb < 4; ++kb) mx = fmaxf(mx, fmaxf(fmaxf(St[kb][qb][0], St[kb][qb][1]), fmaxf(St[kb][qb][2], St[kb][qb][3])));
                        mx = quad_allmax(mx);
                        float mref = mrun[qb];
                        if (__any(mx > mref + 8.0f)) { const float mnew = fmaxf(mref, mx), alpha = __builtin_amdgcn_exp2f(mref - mnew);
#pragma unroll
                            for (int db = 0; db < 4; ++db) O[db][qb] = O[db][qb] * alpha;
                            lrun[qb] *= alpha; mrun[qb] = mnew; mref = mnew; }
                        f32x2 rs2 = (f32x2){0.f, 0.f}; const f32x2 mn2 = (f32x2){mref, mref};
#pragma unroll
                        for (int kb = 0; kb < 4; ++kb)
#pragma unroll
                            for (int r = 0; r < 4; r += 2) { const f32x2 d = (f32x2){St[kb][qb][r], St[kb][qb][r + 1]} - mn2; f32x2 p; p.x = __builtin_amdgcn_exp2f(d.x); p.y = __builtin_amdgcn_exp2f(d.y);
                                St[kb][qb][r] = p.x; St[kb][qb][r + 1] = p.y; rs2 += p; }
                        lrun[qb] += rs2.x + rs2.y;
#pragma unroll
                        for (int ks = 0; ks < 2; ++ks) { u32x4 w;
                            w.x = cvt_pk_bf16(St[2 * ks][qb][0], St[2 * ks][qb][1]); w.y = cvt_pk_bf16(St[2 * ks][qb][2], St[2 * ks][qb][3]);
                            w.z = cvt_pk_bf16(St[2 * ks + 1][qb][0], St[2 * ks + 1][qb][1]); w.w = cvt_pk_bf16(St[2 * ks + 1][qb][2], St[2 * ks + 1][qb][3]);
                            pf[qb][ks] = __builtin_bit_cast(bf16x8, w); }
                    }
                    if (!lagpv) ATT_PV(vt); else { pend = true; pbuf = cb; }
                }
                if (it + 1 < ntile) { const int nbuf = (it + 1) - 3 * ((it + 1) / 3); int t4_ = tid; asm volatile("" : "+v"(t4_)); const int lo_ = (t4_ >> 3) * KS + (t4_ & 7) * 16;
                    *(LAS u32x4*)(kbuf + nbuf * 64 * KS + lo_) = kreg; *(LAS u32x4*)(vbuf + nbuf * 64 * KS + lo_) = vreg; }
                __syncthreads();
            }
            if (lagpv && pend) { ATT_PV(vbuf + pbuf * 64 * KS); }
#undef ATT_PV
#undef LOAD_VFR
            __syncthreads();
#pragma unroll
            for (int qb = 0; qb < 4; ++qb) { const float inv = 1.0f / quad_allsum(lrun[qb]);
                bf16_t* orow = mix + (size_t)(b * SEQ + qw0 + 16 * qb + l15) * DM + hq * 64 + 4 * quad;
#pragma unroll
                for (int db = 0; db < 4; ++db) { const f32x4 o = O[db][qb] * inv; u32x2 w; w.x = cvt_pk_bf16(o[0], o[1]); w.y = cvt_pk_bf16(o[2], o[3]); *(u32x2*)(orow + 16 * db) = w; } }
        }
          for (int blk = bid; blk < NTOK / 64; blk += G) {
            const int t = blk * 64 + (tid & 7) * 8, ch = tid >> 3, c0 = 8 * ch, g = wave >> 1;
            const int s = t & (SEQ - 1);
            const bf16_t* zp = zb + (size_t)(t - s) * NIN + 768 + c0;
            bf16_t* op = mix + (size_t)t * DM + 512 + c0;
            if (g == 0) pool4<2, 8>(zp, s, op); else if (g == 1) pool4<4, 8>(zp, s, op); else if (g == 2) pool4<8, 8>(zp, s, op); else pool4<16, 8>(zp, s, op);
        }
    }
    SEAM(3);

    if (IN(4)) {
        int tid = tid_k; asm volatile("" : "+v"(tid)); const int lane = tid & 63, wave = __builtin_amdgcn_readfirstlane(tid >> 6), gw = bid * NWAVES + wave; (void)lane; (void)gw;
        bf16_t* const mix = (bf16_t*)((unsigned char*)ldp(ptab, 23) + (WS_MIX));
        bf16_t* const WoutT = (bf16_t*)((unsigned char*)ldp(ptab, 23) + (WS_WOUT));
        const float* const x_in = (const float*)ldp(ptab, 0);
        float* const modf = (float*)((unsigned char*)ldp(ptab, 23) + (WS_MODF));
        unsigned char* const outb = (unsigned char*)ldp(ptab, 22);
        pg8::SchedStatic S; S.nM = NTOK / 256; S.nN = DM / 256; S.nwg = S.nM * S.nN; S.G = G; S.c = bid; S.extra = 0; S.extra_pn = 0; S.A = (const char*)mix; S.Bt = (const char*)WoutT; S.K = DM;
        EpiOut E{x_in, modf, outb};
        pg8::gemm_phase<EpiOut, pg8::SchedStatic, false>(lds, S, E);
    }

    if (IN(6)) {
        int tid = tid_k; asm volatile("" : "+v"(tid)); const int lane = tid & 63, wave = __builtin_amdgcn_readfirstlane(tid >> 6), gw = bid * NWAVES + wave; (void)lane; (void)gw;
        unsigned char* const hx8 = (unsigned char*)ldp(ptab, 23) + (WS_HX8);
        const float* const norm2_g = (const float*)ldp(ptab, 7);
        float* const modf = (float*)((unsigned char*)ldp(ptab, 23) + (WS_MODF));
        unsigned char* const outb = (unsigned char*)ldp(ptab, 22);
        bf16_t* const WrT = (bf16_t*)((unsigned char*)ldp(ptab, 23) + (WS_WR));
        const float* const router_bias = (const float*)ldp(ptab, 14);
        unsigned* const counts = (unsigned*)((unsigned char*)ldp(ptab, 23) + (WS_CTL + CTL_CNT));
        unsigned* const asg = (unsigned*)((unsigned char*)ldp(ptab, 23) + (WS_ASG));
        float* const gatev = (float*)((unsigned char*)ldp(ptab, 23) + (WS_GATE));
        int* const rtok_g = (int*)((unsigned char*)ldp(ptab, 23) + (WS_RTOK));
        const int quad = lane >> 4, l15 = lane & 15;
        LAS float* const l_rb = (LAS float*)l_tb;
        for (int bi = bid; bi < NTOK / 128; bi += G) {
            if (tid < 64) l_hist[tid] = 0;
            { const int qb_ = (bi * 128) / SEQ;
              { int t2_ = tid; asm volatile("" : "+v"(t2_)); const int c = t2_ & 127, e0 = t2_ >> 7;
                const f32x4 ga = *(const f32x4*)(norm2_g + 8 * c) * (*(const f32x4*)(modf + qb_ * 6144 + 4 * DM + 8 * c) + 1.0f), gb = *(const f32x4*)(norm2_g + 8 * c + 4) * (*(const f32x4*)(modf + qb_ * 6144 + 4 * DM + 8 * c + 4) + 1.0f);
#pragma unroll
                for (int hh = 0; hh < 2; ++hh) { u32x4 wv[8];
#pragma unroll
                    for (int i = 0; i < 8; ++i) wv[i] = *(const u32x4*)(WrT + (size_t)(e0 + 4 * (8 * hh + i)) * DM + 8 * c);
#pragma unroll
                    for (int i = 0; i < 8; ++i) { const int e = e0 + 4 * (8 * hh + i);
                        u32x4 o; o.x = cvt_pk_bf16(bf_lo(wv[i].x) * ga[0], bf_hi(wv[i].x) * ga[1]); o.y = cvt_pk_bf16(bf_lo(wv[i].y) * ga[2], bf_hi(wv[i].y) * ga[3]);
                        o.z = cvt_pk_bf16(bf_lo(wv[i].z) * gb[0], bf_hi(wv[i].z) * gb[1]); o.w = cvt_pk_bf16(bf_lo(wv[i].w) * gb[2], bf_hi(wv[i].w) * gb[3]);
                        *(LAS u32x4*)(lds + e * 2048 + ((c ^ (4 * (e >> 4) + (e & 3))) << 4)) = o; } } }
              { int t3_ = tid; asm volatile("" : "+v"(t3_)); const int e = t3_ >> 3, part = t3_ & 7; float sacc = 0.f;
#pragma unroll 8
                for (int kk = 0; kk < 16; ++kk) { const int k = part * 128 + kk * 8; const u32x4 wv = *(const u32x4*)(WrT + (size_t)e * DM + k);
                    const f32x4 sa = *(const f32x4*)(modf + qb_ * 6144 + 3 * DM + k), sb = *(const f32x4*)(modf + qb_ * 6144 + 3 * DM + k + 4);
                    sacc += bf_lo(wv.x) * sa[0] + bf_hi(wv.x) * sa[1] + bf_lo(wv.y) * sa[2] + bf_hi(wv.y) * sa[3] + bf_lo(wv.z) * sb[0] + bf_hi(wv.z) * sb[1] + bf_lo(wv.w) * sb[2] + bf_hi(wv.w) * sb[3]; }
                sacc += __shfl_xor(sacc, 1); sacc += __shfl_xor(sacc, 2); sacc += __shfl_xor(sacc, 4);
                if (part == 0) l_rb[e] = sacc; } }
            if (bi == bid) SEAM(4);
            __syncthreads();
            const int t0 = bi * 128 + wave * 16, chunk = (bi * 128) / CH, t = t0 + l15;
            f32x4 g2a[4], sh2a[4];
            { const int q = t0 / SEQ;
#pragma unroll
              for (int hq = 0; hq < 4; ++hq) { const int col = 8 * lane + 512 * (hq >> 1) + 4 * (hq & 1);
                g2a[hq] = *(const f32x4*)(norm2_g + col) * (*(const f32x4*)(modf + q * 6144 + 4 * DM + col) + 1.0f); sh2a[hq] = *(const f32x4*)(modf + q * 6144 + 3 * DM + col); } }
            float rsel = 0.f;
#pragma unroll 8
            for (int r = 0; r < 16; ++r) {
                const int m = t0 + r; unsigned char* rowp = outb + (size_t)m * 4096;
                float v[16]; float ss = 0.f;
#pragma unroll
                for (int h = 0; h < 2; ++h) { const u32x4 w = *(const u32x4*)(rowp + (8 * lane + 512 * h) * 2);
                    v[8 * h + 0] = bf_lo(w.x); v[8 * h + 1] = bf_hi(w.x); v[8 * h + 2] = bf_lo(w.y); v[8 * h + 3] = bf_hi(w.y); v[8 * h + 4] = bf_lo(w.z); v[8 * h + 5] = bf_hi(w.z); v[8 * h + 6] = bf_lo(w.w); v[8 * h + 7] = bf_hi(w.w); }
#pragma unroll
                for (int j = 0; j < 16; ++j) ss += v[j] * v[j];
                const float rstd = rsqrtf(wave_sum(ss) * (1.f / DM) + EPS);
                rsel = (l15 == r) ? rstd : rsel;
#pragma unroll
                for (int h = 0; h < 2; ++h) { const int col = 8 * lane + 512 * h; float o[8];
#pragma unroll
                    for (int hh = 0; hh < 2; ++hh) {
#pragma unroll
                        for (int j = 0; j < 4; ++j) o[4 * hh + j] = (v[8 * h + 4 * hh + j] * rstd) * g2a[2 * h + hh][j] + sh2a[2 * h + hh][j]; }
                    u32x2 w8; int pk = 0;
                    pk = __builtin_amdgcn_cvt_pk_fp8_f32(o[0], o[1], pk, false); pk = __builtin_amdgcn_cvt_pk_fp8_f32(o[2], o[3], pk, true); w8.x = (unsigned)pk;
                    pk = __builtin_amdgcn_cvt_pk_fp8_f32(o[4], o[5], pk, false); pk = __builtin_amdgcn_cvt_pk_fp8_f32(o[6], o[7], pk, true); w8.y = (unsigned)pk;
                    *(u32x2*)(hx8 + (size_t)m * DM + col) = w8; }
            }
            const unsigned char* arow = outb + (size_t)t * 4096 + 16 * quad;
            bf16x8 bfr[32];
#pragma unroll
            for (int s = 0; s < 32; ++s) bfr[s] = *(const bf16x8*)(arow + 64 * s);
            f32x4 acc[4];
#pragma unroll
            for (int nb = 0; nb < 4; ++nb) acc[nb] = (f32x4){0.f, 0.f, 0.f, 0.f};
            const LAS unsigned char* wl = lds + (16 * (l15 >> 2) + (l15 & 3)) * 2048;
#pragma unroll
            for (int s = 0; s < 32; ++s)
#pragma unroll
                for (int nb = 0; nb < 4; ++nb) { const bf16x8 af = *(const LAS bf16x8*)(wl + nb * 4 * 2048 + (((4 * s + quad) ^ l15) << 4)); acc[nb] = __builtin_amdgcn_mfma_f32_16x16x32_bf16(af, bfr[s], acc[nb], 0, 0, 0); }
            float sc[16], cand[16];
#pragma unroll
            for (int nb = 0; nb < 4; ++nb) { const f32x4 bs = *(const f32x4*)(router_bias + 16 * quad + 4 * nb);
                const f32x4 ro = *(const LAS f32x4*)(l_rb + 16 * quad + 4 * nb);
#pragma unroll
                for (int r = 0; r < 4; ++r) { const float sg = 1.0f / (1.0f + __expf(-(acc[nb][r] * rsel + ro[r]))); sc[4 * nb + r] = sg; cand[4 * nb + r] = sg + bs[r]; } }
            float gA, gB;
            { float m1 = -__builtin_inff(), m2 = -__builtin_inff();
#pragma unroll
              for (int i = 0; i < 8; ++i) { const float v = cand[i]; if (v > m1) { m2 = m1; m1 = v; } else if (v > m2) m2 = v; }
              gA = m1 + m2; m1 = -__builtin_inff(); m2 = -__builtin_inff();
#pragma unroll
              for (int i = 8; i < 16; ++i) { const float v = cand[i]; if (v > m1) { m2 = m1; m1 = v; } else if (v > m2) m2 = v; }
              gB = m1 + m2; }
            float gs[8];
#pragma unroll
            for (int q = 0; q < 4; ++q) { gs[2 * q] = __shfl(gA, l15 + 16 * q); gs[2 * q + 1] = __shfl(gB, l15 + 16 * q); }
            unsigned gmask = 0u;
#pragma unroll
            for (int it = 0; it < 4; ++it) { float best = -__builtin_inff(); int bi_ = 0;
#pragma unroll
                for (int g = 0; g < 8; ++g) if (!((gmask >> g) & 1u) && gs[g] > best) { best = gs[g]; bi_ = g; }
                gmask |= 1u << bi_; }
            const bool selA = (gmask >> (2 * quad)) & 1u, selB = (gmask >> (2 * quad + 1)) & 1u;
#pragma unroll
            for (int i = 0; i < 16; ++i) cand[i] = ((i < 8) ? selA : selB) ? cand[i] : -__builtin_inff();
            int esel[8]; float ssel[8]; float ssum = 0.f;
#pragma unroll
            for (int k = 0; k < 8; ++k) {
                float bvv = -__builtin_inff(), bs = 0.f; int bi_ = 0;
#pragma unroll
                for (int i = 0; i < 16; ++i) if (cand[i] > bvv) { bvv = cand[i]; bi_ = i; bs = sc[i]; }
                int be = 16 * quad + bi_;
#pragma unroll
                for (int off = 16; off <= 32; off <<= 1) { const float ov = __shfl_xor(bvv, off), os = __shfl_xor(bs, off); const int oe = __shfl_xor(be, off);
                    if (ov > bvv || (ov == bvv && oe < be)) { bvv = ov; be = oe; bs = os; } }
                esel[k] = be; ssel[k] = bs; ssum += bs;
#pragma unroll
                for (int i = 0; i < 16; ++i) if (be == 16 * quad + i) cand[i] = -__builtin_inff();
            }
            const float rn = 2.5f / ssum;
            int e0 = esel[0], e1 = esel[1]; float g0 = ssel[0], g1 = ssel[1];
#pragma unroll
            for (int q = 1; q < 4; ++q) if (quad == q) { e0 = esel[2 * q]; e1 = esel[2 * q + 1]; g0 = ssel[2 * q]; g1 = ssel[2 * q + 1]; }
            const int r0 = __hip_atomic_fetch_add(l_hist + e0, 1, __ATOMIC_RELAXED, __HIP_MEMORY_SCOPE_WORKGROUP);
            const int r1 = __hip_atomic_fetch_add(l_hist + e1, 1, __ATOMIC_RELAXED, __HIP_MEMORY_SCOPE_WORKGROUP);
            __syncthreads();
            if (tid < 64) { const int hcount = l_hist[tid]; l_base[tid] = hcount ? (int)atomicAdd(counts + (chunk * 64 + tid) * 32, (unsigned)hcount) : 0; }
            __syncthreads();
            const int s0 = l_base[e0] + r0, s1 = l_base[e1] + r1;
            u32x2 pa; pa.x = ((unsigned)e0 << 16) | (unsigned)s0; pa.y = ((unsigned)e1 << 16) | (unsigned)s1;
            *(u32x2*)(asg + (size_t)t * 8 + 2 * quad) = pa;
            f32x2 pg; pg.x = g0 * rn; pg.y = g1 * rn; *(f32x2*)(gatev + (size_t)t * 8 + 2 * quad) = pg;
            rtok_g[((size_t)chunk * 64 + e0) * CH + s0] = t; rtok_g[((size_t)chunk * 64 + e1) * CH + s1] = t;
            __syncthreads();
        }
    }
    SEAM(6);

    {
        if (IN(7) || IN(8)) {
            __syncthreads();
            unsigned* const counts = (unsigned*)((unsigned char*)ldp(ptab, 23) + (WS_CTL + CTL_CNT));
            if (tid_k < 64) {
                const int n = (int)counts[tid_k * 32], tl = (n + 255) >> 8; int ts = tl, ys = n;
#pragma unroll
                for (int off = 1; off < 64; off <<= 1) { const int a = __shfl_up(ts, off), b = __shfl_up(ys, off); if (tid_k >= off) { ts += a; ys += b; } }
                l_tb[tid_k] = ts - tl; l_cnt[tid_k] = n; l_yb[tid_k] = ys - n;
                if (tid_k == 63) { l_tb[NEXP] = ts; l_cnt[NEXP] = CH; l_yb[NEXP] = ys; l_tb[NEXP1] = ts + ((CH + 255) >> 8); } }
            __syncthreads();
        }
        if (IN(7)) {
        int tid = tid_k; asm volatile("" : "+v"(tid)); const int lane = tid & 63, wave = __builtin_amdgcn_readfirstlane(tid >> 6), gw = bid * NWAVES + wave; (void)lane; (void)gw;
            unsigned char* const outb = (unsigned char*)ldp(ptab, 22);
            bf16_t* const WguT = (bf16_t*)((unsigned char*)ldp(ptab, 23) + (WS_WGU));
            bf16_t* const WdT = (bf16_t*)((unsigned char*)ldp(ptab, 23) + (WS_WD));
            int* const rtok_g = (int*)((unsigned char*)ldp(ptab, 23) + (WS_RTOK));
            unsigned char* const Hblk = (unsigned char*)ldp(ptab, 23) + (WS_H) + (size_t)bid * (5 * 65536);
            unsigned char* const hx8 = (unsigned char*)ldp(ptab, 23) + (WS_HX8);
            unsigned char* const Yb = (unsigned char*)ldp(ptab, 23) + (WS_Y);
            const int ntiles = l_tb[NEXP1];
            if (wave == 0) {
                const int tbl = l_tb[lane], tbh = l_tb[64 + (lane < 2 ? lane : 1)];
                int t = 0, e = 0, t0 = 0, eend = __builtin_amdgcn_readlane(tbl, 1);
#pragma nounroll
                for (int i = 0; i <= vb; ++i) {
                    const int remT = ntiles - t, remC = G - i;
                    int lo = remT - 5 * (remC - 1); lo = lo < 0 ? 0 : lo;
                    while (eend <= t && e < NEXP1 - 1) { ++e; const int q = __builtin_amdgcn_readfirstlane(e + 1); eend = q < 64 ? __builtin_amdgcn_readlane(tbl, q) : __builtin_amdgcn_readlane(tbh, q - 64); }
                    int sz = (t + 5 <= eend) ? 5 : 4;
                    sz = sz < lo ? lo : sz; sz = sz > remT ? remT : sz;
                    t0 = t; t += sz;
                }
                if (lane == 0) { ((LAS int*)(lds + L_MISC))[16] = t0; ((LAS int*)(lds + L_MISC))[17] = t; }
            }
            __syncthreads();
            int T = __builtin_amdgcn_readfirstlane(((const LAS int*)(lds + L_MISC))[16]); const int T1 = __builtin_amdgcn_readfirstlane(((const LAS int*)(lds + L_MISC))[17]);
            while (T < T1) {
                int lo_ = 0, hi_ = NEXP1;
                while (hi_ - lo_ > 1) { const int mid = (lo_ + hi_) >> 1; if (l_tb[mid] <= T) lo_ = mid; else hi_ = mid; }
                const int e = __builtin_amdgcn_readfirstlane(lo_), j = __builtin_amdgcn_readfirstlane(T - l_tb[lo_]);
                int m = l_tb[lo_ + 1] - T; m = m < T1 - T ? m : T1 - T; m = __builtin_amdgcn_readfirstlane(m < 5 ? m : 5);
                { pg8::SchedTile S; S.cnt = l_cnt; S.e = e; S.j = j; S.nN = m; S.A = (const char*)hx8; S.Bt = (const char*)WguT; S.bstride = (size_t)512 * DM; S.K = DM / 2; S.rtok = rtok_g; S.tok0 = 0; S.arow = DM; S.aofs = 0;
                  EpiGU E{Hblk, PROBE_F(32)};
                  pg8::gemm_phase<EpiGU, pg8::SchedTile, true, true>(lds, S, E); }
                moe_down_run(lds, Hblk, (const unsigned char*)WdT + (size_t)e * DM * DEXP, Yb, (unsigned char*)ldp(ptab, 23) + (WS_CTL + 524288) + (size_t)bid * 1024, l_yb[e], l_cnt[e], j, m);
                T += m;
            }
        }
        if (IN(8)) {
        int tid = tid_k; asm volatile("" : "+v"(tid)); const int lane = tid & 63, wave = __builtin_amdgcn_readfirstlane(tid >> 6), gw = bid * NWAVES + wave; (void)lane; (void)gw;
            unsigned char* const outb = (unsigned char*)ldp(ptab, 22);
            unsigned* const asg = (unsigned*)((unsigned char*)ldp(ptab, 23) + (WS_ASG));
            float* const gatev = (float*)((unsigned char*)ldp(ptab, 23) + (WS_GATE));
            unsigned char* const Yb = (unsigned char*)ldp(ptab, 23) + (WS_Y);
            float* const modf = (float*)((unsigned char*)ldp(ptab, 23) + (WS_MODF));
            const float* const final_g = (const float*)ldp(ptab, 21);
            float* const out_f = (float*)ldp(ptab, 22);
            const int ck = 0;
            constexpr int PU = 2;
            u32x4 pkA[PU], pkB[PU]; f32x4 gtA[PU], gtB[PU];
#pragma unroll
            for (int u = 0; u < PU; ++u) { const int m0 = ck * CH + gw + u * NGW; const int mc = m0 < (ck + 1) * CH ? m0 : ck * CH + gw;
                pkA[u] = *(const u32x4*)(asg + (size_t)mc * 8); pkB[u] = *(const u32x4*)(asg + (size_t)mc * 8 + 4); gtA[u] = *(const f32x4*)(gatev + (size_t)mc * 8); gtB[u] = *(const f32x4*)(gatev + (size_t)mc * 8 + 4); }
            SEAM(7);
            for (int mb = ck * CH + gw; mb < (ck + 1) * CH; mb += PU * NGW) {
                u32x4 yw[PU][9], xw0[PU], xw1[PU]; float gt[PU][8]; bool ok[PU]; int mm[PU];
#pragma unroll
                for (int u = 0; u < PU; ++u) { const int m_ = mb + u * NGW; ok[u] = m_ < (ck + 1) * CH; const int m = ok[u] ? m_ : mb; mm[u] = m;
                    const unsigned pk[8] = {pkA[u].x, pkA[u].y, pkA[u].z, pkA[u].w, pkB[u].x, pkB[u].y, pkB[u].z, pkB[u].w};
                    gt[u][0] = gtA[u].x; gt[u][1] = gtA[u].y; gt[u][2] = gtA[u].z; gt[u][3] = gtA[u].w; gt[u][4] = gtB[u].x; gt[u][5] = gtB[u].y; gt[u][6] = gtB[u].z; gt[u][7] = gtB[u].w;
#pragma unroll
                    for (int k = 0; k < 9; ++k) { const int yrow = (k < 8) ? l_yb[pk[k] >> 16] + (int)(pk[k] & 0xffffu) : l_yb[NEXP] + (m - ck * CH);
                        yw[u][k] = *(const u32x4*)(Yb + (size_t)yrow * DM + 16 * lane); }
                    const unsigned char* rowp = outb + (size_t)m * 4096;
                    xw0[u] = *(const u32x4*)(rowp + (16 * lane) * 2); xw1[u] = *(const u32x4*)(rowp + (16 * lane + 8) * 2); }
#pragma unroll
                for (int u = 0; u < PU; ++u) { const int mn = mb + (PU + u) * NGW; const int mc = mn < (ck + 1) * CH ? mn : mb;
                    pkA[u] = *(const u32x4*)(asg + (size_t)mc * 8); pkB[u] = *(const u32x4*)(asg + (size_t)mc * 8 + 4); gtA[u] = *(const f32x4*)(gatev + (size_t)mc * 8); gtB[u] = *(const f32x4*)(gatev + (size_t)mc * 8 + 4); }
#pragma unroll
                for (int u = 0; u < PU; ++u) {
                    const int m = mm[u], q = m / SEQ;
                    float a[16];
#pragma unroll
                    for (int j = 0; j < 16; ++j) a[j] = 0.f;
#pragma unroll
                    for (int k = 0; k < 9; ++k) { const float gw_ = (k < 8 ? gt[u][k] : 1.0f) * 0.0625f; const u32x4 w = yw[u][k];
#pragma unroll
                        for (int d = 0; d < 4; ++d) { const f32x2 p0 = __builtin_amdgcn_cvt_pk_f32_fp8((int)w[d], false), p1 = __builtin_amdgcn_cvt_pk_f32_fp8((int)w[d], true);
                            a[4 * d + 0] += gw_ * p0.x; a[4 * d + 1] += gw_ * p0.y; a[4 * d + 2] += gw_ * p1.x; a[4 * d + 3] += gw_ * p1.y; } }
                    float ss = 0.f;
                    const int col = 16 * lane;
#pragma unroll
                    for (int h = 0; h < 2; ++h) { const u32x4 w = h ? xw1[u] : xw0[u];
                        const float x1[8] = {bf_lo(w.x), bf_hi(w.x), bf_lo(w.y), bf_hi(w.y), bf_lo(w.z), bf_hi(w.z), bf_lo(w.w), bf_hi(w.w)};
#pragma unroll
                        for (int hh = 0; hh < 2; ++hh) { const f32x4 g2 = *(const f32x4*)(modf + q * 6144 + 5 * DM + col + 8 * h + 4 * hh);
#pragma unroll
                            for (int j = 0; j < 4; ++j) { const float v = x1[4 * hh + j] + g2[j] * a[8 * h + 4 * hh + j]; a[8 * h + 4 * hh + j] = v; ss += v * v; } } }
                    const float rstd = rsqrtf(wave_sum(ss) * (1.f / DM) + EPS);
                    if (ok[u]) {
#pragma unroll
                        for (int d = 0; d < 4; ++d) { const f32x4 fg = *(const f32x4*)(final_g + col + 4 * d); f32x4 o;
#pragma unroll
                            for (int j = 0; j < 4; ++j) o[j] = a[4 * d + j] * rstd * fg[j];
                            *(f32x4*)(out_f + (size_t)m * DM + col + 4 * d) = o; } }
                }
            }
        }
    }
#undef IN
#undef SEAM
}

extern "C" void kernel_launch(void* const* d_in, const int* in_sizes, int n_in, void* d_out, int out_size, void* d_ws, size_t ws_size, hipStream_t stream) {
    static int grid = 0;
    if (grid == 0) {
        if (n_in != 22 || in_sizes[0] != NTOK * DM || out_size != NTOK * DM || ws_size < WS_END) {
            fprintf(stderr, "kernel_launch: unexpected shapes (n_in %d, in0 %d, out %d, ws %zu, need %zu); nothing launched\n", n_in, n_in > 0 ? in_sizes[0] : -1, out_size, ws_size, (size_t)WS_END); grid = -1; return; }
        int dev = 0, cus = 0, per_cu = 0;
        if (hipGetDevice(&dev) != hipSuccess || hipDeviceGetAttribute(&cus, hipDeviceAttributeMultiprocessorCount, dev) != hipSuccess) { grid = -1; return; }
        if (hipFuncSetAttribute((const void*)fwd, hipFuncAttributeMaxDynamicSharedMemorySize, LDS_BYTES) != hipSuccess) { fprintf(stderr, "kernel_launch: hipFuncSetAttribute failed\n"); grid = -1; return; }
        if (hipOccupancyMaxActiveBlocksPerMultiprocessor(&per_cu, (const void*)fwd, NTHREADS, LDS_BYTES) != hipSuccess || per_cu < 1) { fprintf(stderr, "kernel_launch: occupancy query says %d blocks per CU\n", per_cu); (void)hipGetLastError(); grid = -1; return; }
        grid = cus < 256 ? cus : 256;
    }
    if (grid < 0) return;
    if (hipMemsetAsync((char*)d_ws + WS_CTL, 0, CTL_BYTES, stream) != hipSuccess) return;
    Args a{};
    for (int i = 0; i < 22; ++i) a.in[i] = (const float*)d_in[i];
    a.out = (float*)d_out; a.ws = (unsigned char*)d_ws;
#if MK_PER_PHASE
    for (int ph = 0; ph < NPHASE; ++ph) { a.ph_lo = ph; a.ph_hi = ph + 1; hipLaunchKernelGGL(fwd, dim3(grid), dim3(NTHREADS), LDS_BYTES, stream, a); }
#else
    a.ph_lo = 0; a.ph_hi = NPHASE; hipLaunchKernelGGL(fwd, dim3(grid), dim3(NTHREADS), LDS_BYTES, stream, a);
#endif
}
```
